# Optimizing an MI355X kernel written in HIP

```python
import math
import jax, jax.numpy as jnp
from jax import lax
import numpy as np

D_MODEL = 2048
BATCH = 4
SEQ = 4096
DEPTH = 1

CHUNK = 64
A_HEADS = 4
A_HEAD_DIM = 256
A_WIDTH = A_HEADS * A_HEAD_DIM
CONV_WIDTH = 4
FORGET_BIAS_LO = 3.0
FORGET_BIAS_HI = 6.0
B_HEADS = 8
B_HEAD_DIM = 64
B_V_DIM = 2 * B_HEAD_DIM
B_QK_WIDTH = 2 * B_HEADS * B_HEAD_DIM
B_WIDTH = B_HEADS * B_V_DIM
Q_BLOCK = 128
N_GROUPS = 4
EXPERTS_PER_GROUP = 8
N_EXPERTS = N_GROUPS * EXPERTS_PER_GROUP
TOP_K = 2
D_EXPERT = 512
MOE_BLOCK = 128
DEEPNORM_ALPHA = (2 * DEPTH) ** 0.25
DEEPNORM_BETA = (8 * DEPTH) ** -0.25
LN_EPS = 1e-5
IN_COLS = (A_WIDTH, A_WIDTH, A_WIDTH, A_WIDTH, A_HEADS, A_HEADS,
           B_QK_WIDTH, B_QK_WIDTH, B_WIDTH, D_MODEL, D_MODEL)
V_COL_IDS = (2, 8)
F_COL_ID = 5
N_IN = sum(IN_COLS)

kernel_name = "hybrid_mlstm_diffattn_hmoe_block"


def _col_offsets():
    offs = [0]
    for c in IN_COLS:
        offs.append(offs[-1] + c)
    return offs


def _layer_norm(x, g, b):
    xf = x.astype(jnp.float32)
    mu = jnp.mean(xf, axis=-1, keepdims=True)
    var = jnp.mean(jnp.square(xf - mu), axis=-1, keepdims=True)
    y = (xf - mu) * lax.rsqrt(var + LN_EPS)
    return (y * g + b).astype(x.dtype)


def _causal_dwconv(u, w, bias):
    c = u.shape[-1]
    y = lax.conv_general_dilated(u, w.astype(u.dtype)[:, None, :], window_strides=(1,),
                                 padding=[(CONV_WIDTH - 1, 0)],
                                 dimension_numbers=('NWC', 'WIO', 'NWC'),
                                 feature_group_count=c)
    return y + bias


def _mlstm(q, k, v, i_pre, f_pre):
    B, S, H, dh = q.shape
    nc = S // CHUNK
    f32 = jnp.float32
    to_chunks = lambda t: t.astype(f32).reshape(B, nc, CHUNK, H, dh).transpose(1, 0, 3, 2, 4)
    gate_chunks = lambda t: t.astype(f32).reshape(B, nc, CHUNK, H).transpose(1, 0, 3, 2)
    qc = to_chunks(q)
    kc = to_chunks(k) * (dh ** -0.5)
    vc = to_chunks(v)
    ic = gate_chunks(i_pre)
    lfc = jax.nn.log_sigmoid(gate_chunks(f_pre))
    tril = jnp.tril(jnp.ones((CHUNK, CHUNK), dtype=bool))

    def step(carry, xs):
        C, n, m = carry
        q_, k_, v_, i_, lf_ = xs
        b = jnp.cumsum(lf_, axis=-1)
        dmat = b[..., :, None] - b[..., None, :] + i_[..., None, :]
        dmat = jnp.where(tril, dmat, -jnp.inf)
        inter = b + m[..., None]
        m_t = jnp.maximum(inter, jnp.max(dmat, axis=-1))
        w_intra = jnp.exp(dmat - m_t[..., None]) * jnp.einsum('bhtd,bhsd->bhts', q_, k_)
        w_inter = jnp.exp(inter - m_t)
        num = (w_inter[..., None] * jnp.einsum('bhtk,bhkv->bhtv', q_, C)
               + jnp.einsum('bhts,bhsv->bhtv', w_intra, v_))
        den = w_inter * jnp.einsum('bhtk,bhk->bht', q_, n) + jnp.sum(w_intra, axis=-1)
        h = num / jnp.maximum(jnp.abs(den), jnp.exp(-m_t))[..., None]
        b_last = b[..., -1]
        g = b_last[..., None] - b + i_
        m_new = jnp.maximum(b_last + m, jnp.max(g, axis=-1))
        decay = jnp.exp(b_last + m - m_new)
        wk = jnp.exp(g - m_new[..., None])
        C = decay[..., None, None] * C + jnp.einsum('bhs,bhsk,bhsv->bhkv', wk, k_, v_)
        n = decay[..., None] * n + jnp.einsum('bhs,bhsk->bhk', wk, k_)
        return (C, n, m_new), h

    init = (jnp.zeros((B, H, dh, dh), f32), jnp.zeros((B, H, dh), f32), jnp.zeros((B, H), f32))
    _, h = lax.scan(step, init, (qc, kc, vc, ic, lfc))
    return h.transpose(1, 0, 3, 2, 4).reshape(B, S, H, dh)


def _diff_attention(q, k, v, lam):
    B, S, H, _, d = q.shape
    f32 = jnp.float32
    nqb = S // Q_BLOCK
    q_blocks = jnp.moveaxis(q.reshape(B, nqb, Q_BLOCK, H, 2, d), 1, 0)
    slopes = 2.0 ** (-8.0 * jnp.arange(1, H + 1, dtype=f32) / H)
    k_pos = jnp.arange(S)
    scale = d ** -0.5

    def one_block(args):
        q_blk, blk = args
        q_pos = blk * Q_BLOCK + jnp.arange(Q_BLOCK)
        s = jnp.einsum('bqhnd,bkhnd->bhnqk', q_blk, k).astype(f32) * scale
        dist = jnp.abs(q_pos[:, None] - k_pos[None, :]).astype(f32)
        visible = (k_pos[None, :] // CHUNK) <= (q_pos[:, None] // CHUNK)
        s = jnp.where(visible, s - slopes[None, :, None, None, None] * dist, -jnp.inf)
        p = jax.nn.softmax(s, axis=-1)
        a = p[:, :, 0] - lam * p[:, :, 1]
        return jnp.einsum('bhqk,bkhe->bqhe', a.astype(v.dtype), v)

    o = lax.map(one_block, (q_blocks, jnp.arange(nqb)))
    return jnp.moveaxis(o, 0, 1).reshape(B, S, H, v.shape[-1]).astype(f32)


def _mixer(x, w_in, b_in, conv_w, conv_b, norm_a_g, lq1, lk1, lq2, lk2, norm_b_g,
           w_a, w_b, w_out, lambda_init):
    B, S, _ = x.shape
    f32 = jnp.float32
    offs = _col_offsets()
    z = x @ w_in + b_in
    qa, ka, va, oa, ia, fa, qb, kb, vb, ga, gb = [z[..., offs[j]:offs[j + 1]] for j in range(len(IN_COLS))]
    qk = jax.nn.silu(_causal_dwconv(jnp.concatenate([qa, ka], axis=-1), conv_w, conv_b))
    qa, ka = qk[..., :A_WIDTH], qk[..., A_WIDTH:]
    heads_a = lambda t: t.reshape(B, S, A_HEADS, A_HEAD_DIM)
    h_a = _mlstm(heads_a(qa), heads_a(ka), heads_a(va), ia, fa)
    h_a = jax.nn.sigmoid(oa.astype(f32)).reshape(B, S, A_HEADS, A_HEAD_DIM) * h_a
    mu = jnp.mean(h_a, axis=-1, keepdims=True)
    var = jnp.mean(jnp.square(h_a - mu), axis=-1, keepdims=True)
    h_a = ((h_a - mu) * lax.rsqrt(var + LN_EPS)).reshape(B, S, A_WIDTH) * norm_a_g
    y_a = h_a.astype(x.dtype) @ w_a
    lam = (jnp.exp(jnp.sum(lq1.astype(f32) * lk1.astype(f32)))
           - jnp.exp(jnp.sum(lq2.astype(f32) * lk2.astype(f32))) + lambda_init)
    o_b = _diff_attention(qb.reshape(B, S, B_HEADS, 2, B_HEAD_DIM),
                          kb.reshape(B, S, B_HEADS, 2, B_HEAD_DIM),
                          vb.reshape(B, S, B_HEADS, B_V_DIM), lam)
    o_b = o_b * lax.rsqrt(jnp.mean(jnp.square(o_b), axis=-1, keepdims=True) + LN_EPS) * norm_b_g * (1.0 - lambda_init)
    y_b = o_b.reshape(B, S, B_WIDTH).astype(x.dtype) @ w_b
    merged = jax.nn.sigmoid(ga) * y_a + jax.nn.sigmoid(gb) * y_b
    return merged @ w_out


def _hier_moe(h, w_grp, b_grp, w_exp, b_exp, w_gate, w_up, w_down):
    B, S, D = h.shape
    T = B * S
    M = T * TOP_K
    f32 = jnp.float32
    ht = h.reshape(T, D)
    tok = jnp.arange(T)
    grp_logits = (ht @ w_grp + b_grp).astype(f32)
    grp_sel = jnp.argmax(grp_logits, axis=-1)
    grp_prob = jax.nn.softmax(grp_logits, axis=-1)[tok, grp_sel]
    exp_logits = (ht @ w_exp + b_exp).astype(f32).reshape(T, N_GROUPS, EXPERTS_PER_GROUP)
    in_grp = exp_logits[tok, grp_sel]
    top_val, top_idx = lax.top_k(in_grp, TOP_K)
    slot_w = (grp_prob[:, None] * jax.nn.softmax(top_val, axis=-1)).reshape(M)
    slot_e = (grp_sel[:, None] * EXPERTS_PER_GROUP + top_idx).reshape(M).astype(jnp.int32)
    slot_tok = jnp.repeat(jnp.arange(T, dtype=jnp.int32), TOP_K)
    order = jnp.argsort(slot_e)
    e_sorted = slot_e[order]
    counts = jnp.bincount(slot_e, length=N_EXPERTS)
    starts = jnp.cumsum(counts) - counts
    padded = ((counts + MOE_BLOCK - 1) // MOE_BLOCK) * MOE_BLOCK
    pad_ends = jnp.cumsum(padded)
    pad_starts = pad_ends - padded
    pos = pad_starts[e_sorted] + (jnp.arange(M) - starts[e_sorted])
    n_blocks = M // MOE_BLOCK + N_EXPERTS
    P = n_blocks * MOE_BLOCK
    tok_at = jnp.full((P,), T, jnp.int32).at[pos].set(slot_tok[order])
    w_at = jnp.zeros((P,), f32).at[pos].set(slot_w[order])
    block_e = jnp.clip(jnp.searchsorted(pad_ends, jnp.arange(n_blocks) * MOE_BLOCK, side='right'),
                       0, N_EXPERTS - 1)
    x_pad = jnp.concatenate([ht, jnp.zeros((1, D), ht.dtype)], axis=0)[tok_at].reshape(n_blocks, MOE_BLOCK, D)

    def expert_block(args):
        xb, e = args
        return (jax.nn.silu(xb @ w_gate[e]) * (xb @ w_up[e])) @ w_down[e]

    y = lax.map(expert_block, (x_pad, block_e)).reshape(P, D)
    out = jnp.zeros((T + 1, D), y.dtype).at[tok_at].add(y * w_at[:, None].astype(y.dtype))
    return out[:T].reshape(B, S, D)


def setup_inputs(seed: int = 0) -> dict:
    key = jax.random.key(seed)
    ks = jax.random.split(key, 24)
    nrm = lambda k, shape: jax.random.normal(k, shape, jnp.float32)
    offs = _col_offsets()
    col_scale = jnp.concatenate([jnp.full((c,), DEEPNORM_BETA if j in V_COL_IDS else 1.0, jnp.float32)
                                 for j, c in enumerate(IN_COLS)])
    w_in = nrm(ks[1], (DEPTH, D_MODEL, N_IN)) * (D_MODEL ** -0.5) * col_scale
    b_in = 0.01 * nrm(ks[2], (DEPTH, N_IN))
    b_in = b_in.at[:, offs[F_COL_ID]:offs[F_COL_ID + 1]].add(
        jnp.linspace(FORGET_BIAS_LO, FORGET_BIAS_HI, A_HEADS, dtype=jnp.float32))
    return {
        "x": nrm(ks[0], (BATCH, SEQ, D_MODEL)),
        "w_in": w_in,
        "b_in": b_in,
        "conv_w": nrm(ks[3], (DEPTH, CONV_WIDTH, 2 * A_WIDTH)) * (CONV_WIDTH ** -0.5),
        "conv_b": 0.01 * nrm(ks[4], (DEPTH, 2 * A_WIDTH)),
        "mlstm_norm_g": 1.0 + 0.02 * nrm(ks[5], (DEPTH, A_WIDTH)),
        "lambda_q1": 0.1 * nrm(ks[6], (DEPTH, B_HEAD_DIM)),
        "lambda_k1": 0.1 * nrm(ks[7], (DEPTH, B_HEAD_DIM)),
        "lambda_q2": 0.1 * nrm(ks[8], (DEPTH, B_HEAD_DIM)),
        "lambda_k2": 0.1 * nrm(ks[9], (DEPTH, B_HEAD_DIM)),
        "diff_norm_g": 1.0 + 0.02 * nrm(ks[10], (DEPTH, B_V_DIM)),
        "w_a": nrm(ks[11], (DEPTH, A_WIDTH, D_MODEL)) * (A_WIDTH ** -0.5) * DEEPNORM_BETA,
        "w_b": nrm(ks[12], (DEPTH, B_WIDTH, D_MODEL)) * (B_WIDTH ** -0.5) * DEEPNORM_BETA,
        "w_out": nrm(ks[13], (DEPTH, D_MODEL, D_MODEL)) * (D_MODEL ** -0.5) * DEEPNORM_BETA,
        "ln1_g": 1.0 + 0.02 * nrm(ks[14], (DEPTH, D_MODEL)),
        "ln1_b": 0.02 * nrm(ks[15], (DEPTH, D_MODEL)),
        "w_grp": nrm(ks[16], (DEPTH, D_MODEL, N_GROUPS)) * (D_MODEL ** -0.5),
        "b_grp": 0.01 * nrm(ks[17], (DEPTH, N_GROUPS)),
        "w_exp": nrm(ks[18], (DEPTH, D_MODEL, N_EXPERTS)) * (D_MODEL ** -0.5),
        "b_exp": 0.01 * nrm(ks[19], (DEPTH, N_EXPERTS)),
        "w_gate": nrm(ks[20], (DEPTH, N_EXPERTS, D_MODEL, D_EXPERT)) * (D_MODEL ** -0.5),
        "w_up": nrm(ks[21], (DEPTH, N_EXPERTS, D_MODEL, D_EXPERT)) * (D_MODEL ** -0.5),
        "w_down": nrm(ks[22], (DEPTH, N_EXPERTS, D_EXPERT, D_MODEL)) * (D_EXPERT ** -0.5) * DEEPNORM_BETA,
        "ln2_g": 1.0 + 0.02 * nrm(ks[23], (DEPTH, D_MODEL)),
        "ln2_b": 0.02 * nrm(jax.random.fold_in(ks[23], 1), (DEPTH, D_MODEL)),
    }


def reference(x, w_in, b_in, conv_w, conv_b, mlstm_norm_g, lambda_q1, lambda_k1, lambda_q2, lambda_k2,
              diff_norm_g, w_a, w_b, w_out, ln1_g, ln1_b, w_grp, b_grp, w_exp, b_exp,
              w_gate, w_up, w_down, ln2_g, ln2_b):
    for l in range(DEPTH):
        lambda_init = 0.8 - 0.6 * math.exp(-0.3 * l)
        mix = _mixer(x, w_in[l], b_in[l], conv_w[l], conv_b[l], mlstm_norm_g[l],
                     lambda_q1[l], lambda_k1[l], lambda_q2[l], lambda_k2[l], diff_norm_g[l],
                     w_a[l], w_b[l], w_out[l], lambda_init)
        x = _layer_norm(DEEPNORM_ALPHA * x + mix, ln1_g[l], ln1_b[l])
        ffn = _hier_moe(x, w_grp[l], b_grp[l], w_exp[l], b_exp[l], w_gate[l], w_up[l], w_down[l])
        x = _layer_norm(DEEPNORM_ALPHA * x + ffn, ln2_g[l], ln2_b[l])
    return x
```

```cpp
#include <hip/hip_runtime.h>
#include <cstdio>
#include <cstdint>
#include <cmath>

typedef unsigned short bf16_t;
typedef short bf16x8 __attribute__((ext_vector_type(8)));
typedef float f32x4 __attribute__((ext_vector_type(4)));
typedef float f32x16 __attribute__((ext_vector_type(16)));
typedef unsigned u32x4 __attribute__((ext_vector_type(4)));
typedef unsigned u32x2 __attribute__((ext_vector_type(2)));

constexpr int DM = 2048, BATCH = 4, SEQ = 4096, T_TOK = BATCH * SEQ;
constexpr int N_IN = 11272, N_MAIN = 11264;
constexpr int NEXP = 32, DE = 512;
constexpr float ALPHA = 1.189207115002721f;
constexpr float LN_EPS = 1e-5f;
constexpr float LAMBDA_INIT = 0.2f;
constexpr int PMAX = 40960;

__device__ __forceinline__ float bf2f(bf16_t b) { return __uint_as_float(((unsigned)b) << 16); }
__device__ __forceinline__ unsigned f2bf_u(float f) { unsigned u = __float_as_uint(f); return (u + 0x7fffu + ((u >> 16) & 1u)) >> 16; }
__device__ __forceinline__ bf16_t f2bf(float f) { return (bf16_t)f2bf_u(f); }
__device__ __forceinline__ unsigned pk2(float lo, float hi) { return f2bf_u(lo) | (f2bf_u(hi) << 16); }

constexpr size_t MiB = 1u << 20;
constexpr size_t WS_CTL = 0;
constexpr size_t WS_GATES = 1 * MiB;
constexpr size_t WS_TOKE = 2 * MiB;
constexpr size_t WS_TOKP = 2 * MiB + 256 * 1024;
constexpr size_t WS_TOKW = 2 * MiB + 512 * 1024;
constexpr size_t WS_LIST = 3 * MiB;
constexpr size_t WS_SCAL = 5 * MiB;
constexpr size_t WS_WIN_T = 8 * MiB;
constexpr size_t WS_WA_T = 52 * MiB, WS_WB_T = 56 * MiB, WS_WOUT_T = 60 * MiB;
constexpr size_t WS_XB = 68 * MiB;
constexpr size_t WS_HA = 68 * MiB, WS_OB = 100 * MiB;
constexpr size_t WS_WD_T = 68 * MiB;
constexpr size_t WS_CST = 132 * MiB;
constexpr size_t WS_WGU_T = 132 * MiB;
constexpr size_t WS_ZG = 260 * MiB;
constexpr size_t WS_R = 260 * MiB;
constexpr size_t WS_ZB = 388 * MiB;
constexpr size_t WS_X1B = 388 * MiB;
constexpr size_t WS_Y = 388 * MiB;
constexpr size_t WS_ZA = 484 * MiB;
constexpr size_t WS_MG = 484 * MiB;
constexpr size_t WS_H = 572 * MiB;
constexpr size_t WS_END = 612 * MiB;
constexpr int CW_CNT = 64;
constexpr int CW_BASE = 128;
namespace sp {

__device__ __forceinline__ float wave_sum(float v) {
#pragma unroll
    for (int o = 1; o < 64; o <<= 1) v += __shfl_xor(v, o);
    return v;
}
__device__ __forceinline__ float wave_max(float v) {
#pragma unroll
    for (int o = 1; o < 64; o <<= 1) v = fmaxf(v, __shfl_xor(v, o));
    return v;
}
__device__ __forceinline__ float sigmoidf_(float x) { return 1.f / (1.f + __expf(-x)); }
__device__ __forceinline__ float logsigmoidf_(float x) { return fminf(x, 0.f) - log1pf(__expf(-fabsf(x))); }

__global__ __launch_bounds__(256) void k_gates(const float* __restrict__ x, const float* __restrict__ w_in, const float* __restrict__ b_in, float* __restrict__ gates) {
    const int w = threadIdx.x >> 6, lane = threadIdx.x & 63;
    const int row = blockIdx.x * 4 + w;
    float acc[8];
#pragma unroll
    for (int g = 0; g < 8; ++g) acc[g] = 0.f;
    const float* xr = x + (size_t)row * DM;
#pragma unroll 2
    for (int i = 0; i < 8; ++i) {
        const f32x4 xv = *(const f32x4*)(xr + i * 256 + lane * 4);
#pragma unroll
        for (int e = 0; e < 4; ++e) {
            const float* wp = w_in + (size_t)(i * 256 + lane * 4 + e) * N_IN + 4096;
            const f32x4 w0 = *(const f32x4*)wp, w1 = *(const f32x4*)(wp + 4);
            const float xe = xv[e];
            acc[0] += xe * w0[0]; acc[1] += xe * w0[1]; acc[2] += xe * w0[2]; acc[3] += xe * w0[3];
            acc[4] += xe * w1[0]; acc[5] += xe * w1[1]; acc[6] += xe * w1[2]; acc[7] += xe * w1[3];
        }
    }
#pragma unroll
    for (int g = 0; g < 8; ++g) acc[g] = wave_sum(acc[g]);
    if (lane < 8) {
        float v = acc[0];
#pragma unroll
        for (int g = 1; g < 8; ++g) v = (lane == g) ? acc[g] : v;
        gates[(size_t)row * 8 + lane] = v + b_in[4096 + lane];
    }
}

struct LAf32 { const float* A; int lda; int K;
    __device__ bool valid(int, int) const { return true; }
    __device__ void load16(int tm, int, int r, int k, float (&v)[16]) const { const float* p = A + (size_t)(tm * 128 + r) * lda + k;
#pragma unroll
        for (int i = 0; i < 4; ++i) { const f32x4 t = *(const f32x4*)(p + 4 * i); v[4 * i] = t[0]; v[4 * i + 1] = t[1]; v[4 * i + 2] = t[2]; v[4 * i + 3] = t[3]; } } };
struct LAbf16 { const bf16_t* A; int lda; int K;
    __device__ bool valid(int, int) const { return true; }
    __device__ void load16(int tm, int, int r, int k, float (&v)[16]) const { const bf16_t* p = A + (size_t)(tm * 128 + r) * lda + k;
#pragma unroll
        for (int i = 0; i < 16; ++i) v[i] = bf2f(p[i]); } };
struct LAgather { const bf16_t* X; const int* list; const int* cnt; int K; int pad;
    __device__ bool valid(int tm, int z) const { return tm * 128 < cnt[z]; }
    __device__ void load16(int tm, int z, int r, int k, float (&v)[16]) const { const int idx = tm * 128 + r; const int tok = idx < cnt[z] ? list[z * T_TOK + idx] : 0;
        const bf16_t* p = X + (size_t)tok * DM + k;
#pragma unroll
        for (int i = 0; i < 16; ++i) v[i] = bf2f(p[i]); } };
struct LAhid { const bf16_t* H; const int* base; const int* cnt; int K; int pad;
    __device__ bool valid(int tm, int z) const { return tm * 128 < cnt[z]; }
    __device__ void load16(int tm, int z, int r, int k, float (&v)[16]) const { const bf16_t* p = H + (size_t)(base[z] + tm * 128 + r) * DE + k;
#pragma unroll
        for (int i = 0; i < 16; ++i) v[i] = bf2f(p[i]); } };
struct LBf32 { const float* B0; const float* B1; size_t zstride; int ldb; int remap;
    __device__ void load16(int nb, int z, int k, int n, float (&v)[16]) const { const int ns = (remap && n >= 4096) ? n + 8 : n;
        const float* p = (nb ? B1 : B0) + (size_t)z * zstride + (size_t)k * ldb + ns;
#pragma unroll
        for (int i = 0; i < 4; ++i) { const f32x4 t = *(const f32x4*)(p + 4 * i); v[4 * i] = t[0]; v[4 * i + 1] = t[1]; v[4 * i + 2] = t[2]; v[4 * i + 3] = t[3]; } } };

template <class LA, class LB, class EP, int NB>
__global__ __launch_bounds__(256) void k_sgemm(LA la, LB lb, EP ep) {
    const int K = la.K;
    __shared__ __attribute__((aligned(16))) bf16_t As[128][40];
    __shared__ __attribute__((aligned(16))) bf16_t Bs[NB][128][40];
    const int tid = threadIdx.x, lane = tid & 63, w = tid >> 6, wr = w >> 1, wc = w & 1;
    const int tn = blockIdx.x, tm = blockIdx.y, z = blockIdx.z;
    if (!la.valid(tm, z)) return;
    f32x4 acc[NB][4][4];
#pragma unroll
    for (int b = 0; b < NB; ++b)
#pragma unroll
        for (int i = 0; i < 4; ++i)
#pragma unroll
            for (int j = 0; j < 4; ++j) acc[b][i][j] = (f32x4){0.f, 0.f, 0.f, 0.f};
    for (int k0 = 0; k0 < K; k0 += 32) {
        { const int r = tid >> 1, kh = (tid & 1) * 16; float v[16]; la.load16(tm, z, r, k0 + kh, v);
            u32x4 p0, p1;
            p0.x = pk2(v[0], v[1]); p0.y = pk2(v[2], v[3]); p0.z = pk2(v[4], v[5]); p0.w = pk2(v[6], v[7]);
            p1.x = pk2(v[8], v[9]); p1.y = pk2(v[10], v[11]); p1.z = pk2(v[12], v[13]); p1.w = pk2(v[14], v[15]);
            *(u32x4*)&As[r][kh] = p0; *(u32x4*)&As[r][kh + 8] = p1; }
#pragma unroll
        for (int b = 0; b < NB; ++b) { const int k = tid >> 3, nc = (tid & 7) * 16; float v[16]; lb.load16(b, z, k0 + k, tn * 128 + nc, v);
#pragma unroll
            for (int i = 0; i < 16; ++i) Bs[b][nc + i][k] = f2bf(v[i]); }
        __syncthreads();
        bf16x8 a[4];
#pragma unroll
        for (int mi = 0; mi < 4; ++mi) a[mi] = *(const bf16x8*)&As[64 * wr + 16 * mi + (lane & 15)][8 * (lane >> 4)];
#pragma unroll
        for (int b = 0; b < NB; ++b)
#pragma unroll
            for (int ni = 0; ni < 4; ++ni) { const bf16x8 bb = *(const bf16x8*)&Bs[b][64 * wc + 16 * ni + (lane & 15)][8 * (lane >> 4)];
#pragma unroll
                for (int mi = 0; mi < 4; ++mi) acc[b][mi][ni] = __builtin_amdgcn_mfma_f32_16x16x32_bf16(a[mi], bb, acc[b][mi][ni], 0, 0, 0); }
        __syncthreads();
    }
#pragma unroll
    for (int mi = 0; mi < 4; ++mi)
#pragma unroll
        for (int ni = 0; ni < 4; ++ni)
#pragma unroll
            for (int r = 0; r < 4; ++r) { const int rin = 64 * wr + 16 * mi + 4 * (lane >> 4) + r, col = tn * 128 + 64 * wc + 16 * ni + (lane & 15);
                ep(z, tm, rin, col, acc[0][mi][ni][r], acc[NB - 1][mi][ni][r]); }
}

struct EpIn { const float* b_in; bf16_t* ZA; bf16_t* ZB; bf16_t* ZG;
    __device__ void operator()(int, int tm, int rin, int col, float v, float) const { const size_t row = (size_t)tm * 128 + rin; const int cs = col >= 4096 ? col + 8 : col; const float o = v + b_in[cs];
        if (col < 4096) ZA[row * 4096 + col] = f2bf(o); else if (col < 7168) ZB[row * 3072 + (col - 4096)] = f2bf(o); else ZG[row * 4096 + (col - 7168)] = f2bf(o); } };
struct EpYb { const bf16_t* ZG; float* TMP;
    __device__ void operator()(int, int tm, int rin, int col, float v, float) const { const size_t row = (size_t)tm * 128 + rin; TMP[row * DM + col] = sigmoidf_(bf2f(ZG[row * 4096 + 2048 + col])) * v; } };
struct EpYa { const bf16_t* ZG; const float* TMP; bf16_t* MG;
    __device__ void operator()(int, int tm, int rin, int col, float v, float) const { const size_t row = (size_t)tm * 128 + rin; MG[row * DM + col] = f2bf(sigmoidf_(bf2f(ZG[row * 4096 + col])) * v + TMP[row * DM + col]); } };
struct EpOut { const float* x; float* R;
    __device__ void operator()(int, int tm, int rin, int col, float v, float) const { const size_t i = ((size_t)tm * 128 + rin) * DM + col; R[i] = ALPHA * x[i] + v; } };
struct EpUp { bf16_t* H; const int* base;
    __device__ void operator()(int z, int tm, int rin, int col, float g, float u) const { H[(size_t)(base[z] + tm * 128 + rin) * DE + col] = f2bf(g / (1.f + __expf(-g)) * u); } };
struct EpDown { bf16_t* Y; const int* base;
    __device__ void operator()(int z, int tm, int rin, int col, float v, float) const { Y[(size_t)(base[z] + tm * 128 + rin) * DM + col] = f2bf(v); } };

__global__ __launch_bounds__(512) void k_mlstm_rec(const bf16_t* __restrict__ ZA, const float* __restrict__ gates, const float* __restrict__ conv_w, const float* __restrict__ conv_b,
                                                    const float* __restrict__ norm_g, bf16_t* __restrict__ HA) {
    const int bh = blockIdx.x, b = bh >> 2, h = bh & 3;
    const int tid = threadIdx.x, j = tid & 255, kq = tid >> 8, lane = tid & 63, wv = tid >> 6;
    __shared__ float qs[256], ks[256], red[2][256], sred[8], sred2[8], sred3[8];
    float C[128];
#pragma unroll
    for (int i = 0; i < 128; ++i) C[i] = 0.f;
    float nreg = 0.f, m = 0.f;
    const int chan = (tid < 256) ? (h * 256 + tid) : (1024 + h * 256 + (tid - 256));
    float cw0 = 0, cw1 = 0, cw2 = 0, cw3 = 0, cb = 0, z1 = 0, z2 = 0, z3 = 0;
    if (tid < 512) { cw0 = conv_w[chan]; cw1 = conv_w[2048 + chan]; cw2 = conv_w[4096 + chan]; cw3 = conv_w[6144 + chan]; cb = conv_b[chan]; }
    const float gch = norm_g[h * 256 + j];
    for (int t = 0; t < SEQ; ++t) {
        const size_t row = (size_t)b * SEQ + t;
        if (tid < 512) { const float zc = bf2f(ZA[row * 4096 + chan]); const float val = cw0 * z3 + cw1 * z2 + cw2 * z1 + cw3 * zc + cb; z3 = z2; z2 = z1; z1 = zc;
            float s = val / (1.f + __expf(-val)); if (tid < 256) qs[tid] = s; else ks[tid - 256] = s * 0.0625f; }
        __syncthreads();
        const float ig = gates[row * 8 + h], fg = gates[row * 8 + 4 + h];
        const float lf = logsigmoidf_(fg);
        const float m_new = fmaxf(lf + m, ig), fd = __expf(lf + m - m_new), iw = __expf(ig - m_new); m = m_new;
        const float vj = bf2f(ZA[row * 4096 + 2048 + h * 256 + j]);
        float part = 0.f;
#pragma unroll
        for (int kk = 0; kk < 128; ++kk) { const int ki = kq * 128 + kk; C[kk] = fd * C[kk] + iw * ks[ki] * vj; part += qs[ki] * C[kk]; }
        red[kq][j] = part;
        float dpart = 0.f;
        if (tid < 256) { nreg = fd * nreg + iw * ks[tid]; dpart = qs[tid] * nreg; }
        dpart = wave_sum(dpart);
        if (tid < 256 && lane == 0) sred[wv] = dpart;
        __syncthreads();
        float hv = 0.f;
        if (tid < 256) { const float num = red[0][j] + red[1][j]; const float den = sred[0] + sred[1] + sred[2] + sred[3];
            const float hval = num / fmaxf(fabsf(den), __expf(-m));
            hv = sigmoidf_(bf2f(ZA[row * 4096 + 3072 + h * 256 + j])) * hval; }
        float s1 = wave_sum(hv);
        if (tid < 256 && lane == 0) sred2[wv] = s1;
        __syncthreads();
        const float mu = (sred2[0] + sred2[1] + sred2[2] + sred2[3]) * (1.f / 256.f);
        const float dv = (tid < 256) ? (hv - mu) : 0.f;
        float s2 = wave_sum(dv * dv);
        if (tid < 256 && lane == 0) sred3[wv] = s2;
        __syncthreads();
        if (tid < 256) { const float var = (sred3[0] + sred3[1] + sred3[2] + sred3[3]) * (1.f / 256.f);
            HA[row * 1024 + h * 256 + j] = f2bf(dv * rsqrtf(var + LN_EPS) * gch); }
    }
}

__global__ __launch_bounds__(256) void k_attn_simple(const bf16_t* __restrict__ ZB, const float* __restrict__ lq1, const float* __restrict__ lk1, const float* __restrict__ lq2, const float* __restrict__ lk2,
                                                     const float* __restrict__ dng, bf16_t* __restrict__ OB) {
    __shared__ float qs[4][128];
    const int w = threadIdx.x >> 6, lane = threadIdx.x & 63;
    const int idx = blockIdx.x * 4 + w;
    const int t = idx & (SEQ - 1), h = (idx >> 12) & 7, b = idx >> 15;
    const size_t row = (size_t)b * SEQ + t;
    qs[w][lane] = bf2f(ZB[row * 3072 + h * 128 + lane]) * 0.125f;
    qs[w][64 + lane] = bf2f(ZB[row * 3072 + h * 128 + 64 + lane]) * 0.125f;
    __syncthreads();
    const float lam = __expf(wave_sum(lq1[lane] * lk1[lane])) - __expf(wave_sum(lq2[lane] * lk2[lane])) + LAMBDA_INIT;
    const float slope = exp2f(-(float)(h + 1));
    const int kend = ((t >> 6) + 1) << 6;
    float m0 = -INFINITY, m1 = -INFINITY;
    for (int k0 = 0; k0 < kend; k0 += 64) {
        const int k = k0 + lane; const bf16_t* kp = ZB + ((size_t)b * SEQ + k) * 3072 + 1024 + h * 128;
        float s0 = 0.f, s1 = 0.f;
#pragma unroll 8
        for (int d = 0; d < 64; ++d) { s0 += qs[w][d] * bf2f(kp[d]); s1 += qs[w][64 + d] * bf2f(kp[64 + d]); }
        const float bias = slope * fabsf((float)(t - k)); s0 -= bias; s1 -= bias;
        m0 = fmaxf(m0, s0); m1 = fmaxf(m1, s1);
    }
    m0 = wave_max(m0); m1 = wave_max(m1);
    float l0 = 0.f, l1 = 0.f, a00 = 0.f, a01 = 0.f, a10 = 0.f, a11 = 0.f;
    for (int k0 = 0; k0 < kend; k0 += 64) {
        const int k = k0 + lane; const bf16_t* kp = ZB + ((size_t)b * SEQ + k) * 3072 + 1024 + h * 128;
        float s0 = 0.f, s1 = 0.f;
#pragma unroll 8
        for (int d = 0; d < 64; ++d) { s0 += qs[w][d] * bf2f(kp[d]); s1 += qs[w][64 + d] * bf2f(kp[64 + d]); }
        const float bias = slope * fabsf((float)(t - k)); s0 -= bias; s1 -= bias;
        const float p0 = __expf(s0 - m0), p1 = __expf(s1 - m1); l0 += p0; l1 += p1;
        for (int kk = 0; kk < 64; ++kk) { const float c0 = __shfl(p0, kk), c1 = __shfl(p1, kk);
            const bf16_t* vr = ZB + ((size_t)b * SEQ + k0 + kk) * 3072 + 2048 + h * 128;
            const float v0 = bf2f(vr[lane]), v1 = bf2f(vr[64 + lane]);
            a00 += c0 * v0; a01 += c0 * v1; a10 += c1 * v0; a11 += c1 * v1; }
    }
    l0 = wave_sum(l0); l1 = wave_sum(l1);
    const float olo = a00 / l0 - lam * a10 / l1, ohi = a01 / l0 - lam * a11 / l1;
    const float ms = wave_sum(olo * olo + ohi * ohi) * (1.f / 128.f);
    const float r = rsqrtf(ms + LN_EPS) * (1.f - LAMBDA_INIT);
    OB[row * 1024 + h * 128 + lane] = f2bf(olo * r * dng[lane]);
    OB[row * 1024 + h * 128 + 64 + lane] = f2bf(ohi * r * dng[64 + lane]);
}

__global__ __launch_bounds__(256) void k_ln1_route(float* __restrict__ R  , bf16_t* __restrict__ X1B, const float* __restrict__ g1, const float* __restrict__ b1,
                                                   const float* __restrict__ w_grp, const float* __restrict__ b_grp, const float* __restrict__ w_exp, const float* __restrict__ b_exp,
                                                   int* __restrict__ cnt, int* __restrict__ list, int* __restrict__ tok_e, int* __restrict__ tok_pos, float* __restrict__ tok_w) {
    const int w = threadIdx.x >> 6, lane = threadIdx.x & 63;
    const int row = blockIdx.x * 4 + w;
    float* rr = R + (size_t)row * DM;
    f32x4 v[8]; float s = 0.f;
#pragma unroll
    for (int i = 0; i < 8; ++i) { v[i] = *(const f32x4*)(rr + i * 256 + lane * 4); s += (v[i][0] + v[i][1]) + (v[i][2] + v[i][3]); }
    const float mu = wave_sum(s) * (1.f / DM); float q = 0.f;
#pragma unroll
    for (int i = 0; i < 8; ++i) { v[i] = v[i] - mu; q += (v[i][0] * v[i][0] + v[i][1] * v[i][1]) + (v[i][2] * v[i][2] + v[i][3] * v[i][3]); }
    const float rstd = rsqrtf(wave_sum(q) * (1.f / DM) + LN_EPS);
    float lg[36];
#pragma unroll
    for (int c = 0; c < 36; ++c) lg[c] = 0.f;
#pragma unroll
    for (int i = 0; i < 8; ++i) { const int d0 = i * 256 + lane * 4; const f32x4 gg = *(const f32x4*)(g1 + d0), bb = *(const f32x4*)(b1 + d0);
        v[i] = v[i] * rstd * gg + bb;
        *(f32x4*)(rr + d0) = v[i];
        uint2 pk; pk.x = pk2(v[i][0], v[i][1]); pk.y = pk2(v[i][2], v[i][3]); *(uint2*)(X1B + (size_t)row * DM + d0) = pk;
#pragma unroll
        for (int e = 0; e < 4; ++e) { const float xe = v[i][e]; const f32x4 wg = *(const f32x4*)(w_grp + (size_t)(d0 + e) * 4);
            lg[0] += xe * wg[0]; lg[1] += xe * wg[1]; lg[2] += xe * wg[2]; lg[3] += xe * wg[3];
            const float* we = w_exp + (size_t)(d0 + e) * 32;
#pragma unroll
            for (int c4 = 0; c4 < 8; ++c4) { const f32x4 ww = *(const f32x4*)(we + 4 * c4); lg[4 + 4 * c4] += xe * ww[0]; lg[5 + 4 * c4] += xe * ww[1]; lg[6 + 4 * c4] += xe * ww[2]; lg[7 + 4 * c4] += xe * ww[3]; } } }
#pragma unroll
    for (int c = 0; c < 36; ++c) lg[c] = wave_sum(lg[c]);
    if (lane == 0) {
        float gl[4]; int gs = 0; float gm = -INFINITY;
#pragma unroll
        for (int c = 0; c < 4; ++c) { gl[c] = lg[c] + b_grp[c]; if (gl[c] > gm) { gm = gl[c]; gs = c; } }
        float den = 0.f;
#pragma unroll
        for (int c = 0; c < 4; ++c) den += __expf(gl[c] - gm);
        const float gp = 1.f / den;
        float v0 = -INFINITY, v1 = -INFINITY; int i0 = 0, i1 = 0;
#pragma unroll
        for (int c = 0; c < 32; ++c) { const float val = lg[4 + c] + b_exp[c]; const bool in = (c >> 3) == gs;
            if (in) { if (val > v0) { v1 = v0; i1 = i0; v0 = val; i0 = c; } else if (val > v1) { v1 = val; i1 = c; } } }
        const float w0 = 1.f / (1.f + __expf(v1 - v0)), w1 = 1.f - w0;
        const int p0 = atomicAdd(&cnt[i0], 1), p1 = atomicAdd(&cnt[i1], 1);
        list[i0 * T_TOK + p0] = row; list[i1 * T_TOK + p1] = row;
        tok_e[row * 2] = i0; tok_e[row * 2 + 1] = i1; tok_pos[row * 2] = p0; tok_pos[row * 2 + 1] = p1; tok_w[row * 2] = gp * w0; tok_w[row * 2 + 1] = gp * w1;
    }
}
__global__ void k_moe_prefix(const int* __restrict__ cnt, int* __restrict__ base) {
    if (threadIdx.x == 0) { int acc = 0; for (int e = 0; e < NEXP; ++e) { base[e] = acc; acc += ((cnt[e] + 255) / 256) * 256; } base[NEXP] = acc; }
}
__global__ __launch_bounds__(256) void k_ln2(const float* __restrict__ X1, const bf16_t* __restrict__ Y, const int* __restrict__ base, const int* __restrict__ tok_e, const int* __restrict__ tok_pos,
                                             const float* __restrict__ tok_w, const float* __restrict__ g2, const float* __restrict__ b2, float* __restrict__ out) {
    const int w = threadIdx.x >> 6, lane = threadIdx.x & 63;
    const int row = blockIdx.x * 4 + w;
    const size_t r0 = (size_t)(base[tok_e[row * 2]] + tok_pos[row * 2]) * DM, r1 = (size_t)(base[tok_e[row * 2 + 1]] + tok_pos[row * 2 + 1]) * DM;
    const float w0 = tok_w[row * 2], w1 = tok_w[row * 2 + 1];
    f32x4 v[8]; float s = 0.f;
#pragma unroll
    for (int i = 0; i < 8; ++i) { const int d0 = i * 256 + lane * 4; const f32x4 xv = *(const f32x4*)(X1 + (size_t)row * DM + d0);
        const uint2 y0 = *(const uint2*)(Y + r0 + d0), y1 = *(const uint2*)(Y + r1 + d0);
        f32x4 t;
        t[0] = ALPHA * xv[0] + w0 * __uint_as_float(y0.x << 16) + w1 * __uint_as_float(y1.x << 16);
        t[1] = ALPHA * xv[1] + w0 * __uint_as_float(y0.x & 0xffff0000u) + w1 * __uint_as_float(y1.x & 0xffff0000u);
        t[2] = ALPHA * xv[2] + w0 * __uint_as_float(y0.y << 16) + w1 * __uint_as_float(y1.y << 16);
        t[3] = ALPHA * xv[3] + w0 * __uint_as_float(y0.y & 0xffff0000u) + w1 * __uint_as_float(y1.y & 0xffff0000u);
        v[i] = t; s += (t[0] + t[1]) + (t[2] + t[3]); }
    const float mu = wave_sum(s) * (1.f / DM); float q = 0.f;
#pragma unroll
    for (int i = 0; i < 8; ++i) { v[i] = v[i] - mu; q += (v[i][0] * v[i][0] + v[i][1] * v[i][1]) + (v[i][2] * v[i][2] + v[i][3] * v[i][3]); }
    const float rstd = rsqrtf(wave_sum(q) * (1.f / DM) + LN_EPS);
#pragma unroll
    for (int i = 0; i < 8; ++i) { const int d0 = i * 256 + lane * 4; const f32x4 gg = *(const f32x4*)(g2 + d0), bb = *(const f32x4*)(b2 + d0);
        *(f32x4*)(out + (size_t)row * DM + d0) = v[i] * rstd * gg + bb; }
}
}
static void launch_simple(void* const* d_in, float* out, unsigned char* ws, hipStream_t st) {
    const float* x = (const float*)d_in[0]; const float* w_in = (const float*)d_in[1]; const float* b_in = (const float*)d_in[2];
    const float* conv_w = (const float*)d_in[3]; const float* conv_b = (const float*)d_in[4]; const float* norm_a_g = (const float*)d_in[5];
    const float* lq1 = (const float*)d_in[6]; const float* lk1 = (const float*)d_in[7]; const float* lq2 = (const float*)d_in[8]; const float* lk2 = (const float*)d_in[9];
    const float* dng = (const float*)d_in[10]; const float* w_a = (const float*)d_in[11]; const float* w_b = (const float*)d_in[12]; const float* w_out = (const float*)d_in[13];
    const float* ln1_g = (const float*)d_in[14]; const float* ln1_b = (const float*)d_in[15]; const float* w_grp = (const float*)d_in[16]; const float* b_grp = (const float*)d_in[17];
    const float* w_exp = (const float*)d_in[18]; const float* b_exp = (const float*)d_in[19]; const float* w_gate = (const float*)d_in[20]; const float* w_up = (const float*)d_in[21];
    const float* w_down = (const float*)d_in[22]; const float* ln2_g = (const float*)d_in[23]; const float* ln2_b = (const float*)d_in[24];
    float* gates = (float*)(ws + WS_GATES); int* tok_e = (int*)(ws + WS_TOKE); int* tok_p = (int*)(ws + WS_TOKP); float* tok_w = (float*)(ws + WS_TOKW); int* list = (int*)(ws + WS_LIST);
    bf16_t* ZA = (bf16_t*)(ws + WS_ZA); bf16_t* ZB = (bf16_t*)(ws + WS_ZB); bf16_t* ZG = (bf16_t*)(ws + WS_ZG);
    bf16_t* HA = (bf16_t*)(ws + WS_HA); bf16_t* OB = (bf16_t*)(ws + WS_OB); float* TMP = (float*)(ws + WS_CST); bf16_t* MG = (bf16_t*)(ws + WS_MG);
    float* R = (float*)(ws + WS_R); bf16_t* X1B = (bf16_t*)(ws + WS_X1B); bf16_t* H = (bf16_t*)(ws + WS_H); bf16_t* Y = (bf16_t*)(ws + WS_Y);
    int* cnt = (int*)(ws + WS_CTL) + CW_CNT; int* base = (int*)(ws + WS_CTL) + CW_BASE;
    using namespace sp;
    hipLaunchKernelGGL(k_gates, dim3(T_TOK / 4), dim3(256), 0, st, x, w_in, b_in, gates);
    { LAf32 la{x, DM, DM}; LBf32 lb{w_in, w_in, 0, N_IN, 1}; EpIn ep{b_in, ZA, ZB, ZG};
      hipLaunchKernelGGL((k_sgemm<LAf32, LBf32, EpIn, 1>), dim3(N_MAIN / 128, T_TOK / 128, 1), dim3(256), 0, st, la, lb, ep); }
    hipLaunchKernelGGL(k_mlstm_rec, dim3(16), dim3(512), 0, st, ZA, gates, conv_w, conv_b, norm_a_g, HA);
    hipLaunchKernelGGL(k_attn_simple, dim3(BATCH * 8 * SEQ / 4), dim3(256), 0, st, ZB, lq1, lk1, lq2, lk2, dng, OB);
    { LAbf16 la{OB, 1024, 1024}; LBf32 lb{w_b, w_b, 0, DM, 0}; EpYb ep{ZG, TMP};
      hipLaunchKernelGGL((k_sgemm<LAbf16, LBf32, EpYb, 1>), dim3(DM / 128, T_TOK / 128, 1), dim3(256), 0, st, la, lb, ep); }
    { LAbf16 la{HA, 1024, 1024}; LBf32 lb{w_a, w_a, 0, DM, 0}; EpYa ep{ZG, TMP, MG};
      hipLaunchKernelGGL((k_sgemm<LAbf16, LBf32, EpYa, 1>), dim3(DM / 128, T_TOK / 128, 1), dim3(256), 0, st, la, lb, ep); }
    { LAbf16 la{MG, DM, DM}; LBf32 lb{w_out, w_out, 0, DM, 0}; EpOut ep{x, R};
      hipLaunchKernelGGL((k_sgemm<LAbf16, LBf32, EpOut, 1>), dim3(DM / 128, T_TOK / 128, 1), dim3(256), 0, st, la, lb, ep); }
    hipLaunchKernelGGL(k_ln1_route, dim3(T_TOK / 4), dim3(256), 0, st, R, X1B, ln1_g, ln1_b, w_grp, b_grp, w_exp, b_exp, cnt, list, tok_e, tok_p, tok_w);
    hipLaunchKernelGGL(k_moe_prefix, dim3(1), dim3(64), 0, st, cnt, base);
    { LAgather la{X1B, list, cnt, DM, 0}; LBf32 lb{w_gate, w_up, (size_t)DM * DE, DE, 0}; EpUp ep{H, base};
      hipLaunchKernelGGL((k_sgemm<LAgather, LBf32, EpUp, 2>), dim3(DE / 128, T_TOK / 128, NEXP), dim3(256), 0, st, la, lb, ep); }
    { LAhid la{H, base, cnt, DE, 0}; LBf32 lb{w_down, w_down, (size_t)DE * DM, DM, 0}; EpDown ep{Y, base};
      hipLaunchKernelGGL((k_sgemm<LAhid, LBf32, EpDown, 1>), dim3(DM / 128, T_TOK / 128, NEXP), dim3(256), 0, st, la, lb, ep); }
    hipLaunchKernelGGL(k_ln2, dim3(T_TOK / 4), dim3(256), 0, st, R, Y, base, tok_e, tok_p, tok_w, ln2_g, ln2_b, out);
}
extern "C" void kernel_launch(void* const* d_in, const int* in_sizes, int n_in, void* d_out, int out_size, void* d_ws, size_t ws_size, hipStream_t stream) {
    if (n_in != 25 || out_size != T_TOK * DM || ws_size < WS_END) { fprintf(stderr, "kernel_launch: unexpected arguments (n_in %d out %d ws %zu)\n", n_in, out_size, ws_size); return; }
    (void)in_sizes;
    (void)hipMemsetAsync((char*)d_ws + WS_CTL, 0, 1 * MiB, stream);
    launch_simple(d_in, (float*)d_out, (unsigned char*)d_ws, stream);
}
```

```cpp
#include <hip/hip_runtime.h>
#include <cstdio>
#include <cstdint>
#include <cmath>

typedef unsigned short bf16_t;
typedef short bf16x8 __attribute__((ext_vector_type(8)));
typedef float f32x4 __attribute__((ext_vector_type(4)));
typedef float f32x16 __attribute__((ext_vector_type(16)));
typedef unsigned u32x4 __attribute__((ext_vector_type(4)));
typedef unsigned u32x2 __attribute__((ext_vector_type(2)));

constexpr int DM = 2048, BATCH = 4, SEQ = 4096, T_TOK = BATCH * SEQ;
constexpr int N_IN = 11272, N_MAIN = 11264;
constexpr int NEXP = 32, DE = 512;
constexpr float ALPHA = 1.189207115002721f;
constexpr float LN_EPS = 1e-5f;
constexpr float LAMBDA_INIT = 0.2f;
constexpr int PMAX = 40960;

__device__ __forceinline__ float bf2f(bf16_t b) { return __uint_as_float(((unsigned)b) << 16); }
__device__ __forceinline__ unsigned f2bf_u(float f) { unsigned u = __float_as_uint(f); return (u + 0x7fffu + ((u >> 16) & 1u)) >> 16; }
__device__ __forceinline__ bf16_t f2bf(float f) { return (bf16_t)f2bf_u(f); }
__device__ __forceinline__ unsigned pk2(float lo, float hi) { return f2bf_u(lo) | (f2bf_u(hi) << 16); }

constexpr size_t MiB = 1u << 20;
constexpr size_t WS_CTL = 0;
constexpr size_t WS_GATES = 1 * MiB;
constexpr size_t WS_TOKE = 2 * MiB;
constexpr size_t WS_TOKP = 2 * MiB + 256 * 1024;
constexpr size_t WS_TOKW = 2 * MiB + 512 * 1024;
constexpr size_t WS_LIST = 3 * MiB;
constexpr size_t WS_SCAL = 5 * MiB;
constexpr size_t WS_WRT = 7 * MiB;
constexpr size_t WS_WIN_T = 8 * MiB;
constexpr size_t WS_WA_T = 52 * MiB, WS_WB_T = 56 * MiB, WS_WOUT_T = 60 * MiB;
constexpr size_t WS_XB = 68 * MiB;
constexpr size_t WS_HA = 68 * MiB, WS_OB = 100 * MiB;
constexpr size_t WS_WD_T = 68 * MiB;
constexpr size_t WS_CST = 132 * MiB;
constexpr size_t WS_WGU_T = 132 * MiB;
constexpr size_t WS_ZG = 260 * MiB;
constexpr size_t WS_R = 260 * MiB;
constexpr size_t WS_ZB = 388 * MiB;
constexpr size_t WS_X1B = 388 * MiB;
constexpr size_t WS_Y = 388 * MiB;
constexpr size_t WS_ZA = 484 * MiB;
constexpr size_t WS_MG = 484 * MiB;
constexpr size_t WS_H = 572 * MiB;
constexpr size_t WS_END = 612 * MiB;
constexpr int CW_CNT = 64;
constexpr int CW_BASE = 128;
constexpr int CW_STATS = 131072;
namespace pg8 {
#define PG8_LAS __attribute__((address_space(3)))
constexpr int BM = 256, BK = 64, HALF = 128, HTB = HALF * BK * 2, STAGE_BYTES = 8 * HTB, NXCD = 8, WGM = 8;

__host__ __device__ __forceinline__ int lds_byte(int r, int c) { const int st = (r >> 4) * 2 + (c >> 5), rr = r & 15, cc = c & 31, ob = rr * 64 + cc * 2; return st * 1024 + (ob ^ (((ob >> 9) & 1) << 5)); }
__host__ __device__ __forceinline__ void stage_rc(int b, int& R, int& C) { const int st = b / 1024, sb = b % 1024, swz = sb ^ (((sb >> 9) & 1) << 5); R = (st >> 1) * 16 + swz / 64; C = (st & 1) * 32 + (swz % 64) / 2; }
__host__ __device__ __forceinline__ int perm32(int rho) { const int n = rho >> 4, i = rho & 15; return 8 * (i >> 2) + 4 * n + (i & 3); }

struct Unit { int pm, pn, e, pad; const char* abase; const char* bbase; const int* arow; };

struct GridOrder {
    int nM, nN, nwg, G, c; const char* A; const char* Bt; size_t a_tstep, b_tstep;
    __device__ void init(const void* A_, int lda_bytes, const void* Bt_, int ldb_bytes, int M, int N, int G_, int c_) { nM = M / BM; nN = N / BM; nwg = nM * nN; G = G_; c = c_; A = (const char*)A_; Bt = (const char*)Bt_;
        a_tstep = (size_t)BM * lda_bytes; b_tstep = (size_t)BM * ldb_bytes; }
    __device__ bool next(int i, Unit& u) const {
        const long L = (long)i * G + c; if (L >= nwg) return false;
        int wgid = (int)L; { const int q = nwg / NXCD, r = nwg % NXCD, xcd = wgid % NXCD, off = wgid / NXCD; wgid = (xcd < r ? xcd * (q + 1) : r * (q + 1) + (xcd - r) * q) + off; }
        const int nig = WGM * nN, gid = wgid / nig, fm = gid * WGM, gsz = (nM - fm) < WGM ? (nM - fm) : WGM;
        u.pm = fm + ((wgid % nig) % gsz); u.pn = (wgid % nig) / gsz; u.e = 0; u.pad = 0;
        u.abase = A + (size_t)u.pm * a_tstep; u.bbase = Bt + (size_t)u.pn * b_tstep; u.arow = nullptr; return true;
    }
};

struct GridOrder2K {
    GridOrder g; size_t khalf_bytes;
    __device__ bool next(int i, Unit& u) const { if (!g.next(i >> 1, u)) return false; const int h = i & 1; u.e = h ? 0 : 1; u.abase += (size_t)h * khalf_bytes; u.bbase += (size_t)h * khalf_bytes; return true; }
};

__device__ __forceinline__ unsigned cvt_pk_bf16(float lo, float hi) { unsigned r; asm volatile("v_cvt_pk_bf16_f32 %0, %1, %2" : "=v"(r) : "v"(lo), "v"(hi)); return r; }

typedef f32x4 acc_t[2][2][4][2];

template <class Epi, class Sched, bool GATHER = false, bool MIDHOOK = false>
__device__ __forceinline__ void gemm_phase(PG8_LAS unsigned char* lds, const int tid, const int K, const int lda_b  , const int ldb_b  , const Sched& S, const Epi& E) {
    const int wid = __builtin_amdgcn_readfirstlane(tid >> 6), lane = tid & 63, wr = wid >> 2, wc = wid & 3, fr = lane & 15, fq = lane >> 4;
    const int nt = K / BK;
    unsigned vA[2][2], vAn[2][2], voffB[2];
#pragma unroll
    for (int i = 0; i < 2; ++i) { int R, C; stage_rc(tid * 16 + i * 8192, R, C); const int Rb = Epi::PERM ? ((R & ~31) + perm32(R & 31)) : R;
        voffB[i] = (unsigned)(Rb * ldb_b + C * 2);
        vA[0][i] = (unsigned)(R * lda_b + C * 2); vA[1][i] = (unsigned)((R + HALF) * lda_b + C * 2); vAn[0][i] = vA[0][i]; vAn[1][i] = vA[1][i]; }
    const size_t kstep = (size_t)(BK * 2);
    const size_t hstepB = (size_t)HALF * ldb_b;
    const unsigned ldsw = (unsigned)wid * 1024u;
    const int aoff = lds_byte(wr * 64 + fr, fq * 8), boff = lds_byte(wc * 32 + fr, fq * 8);
#define PG8_SA(b, h) (((b) * 2 + (h)) * HTB)
#define PG8_SB(b, h) ((4 + (b) * 2 + (h)) * HTB)
#define PG8_STAGE(bufoff, gbase, voff) do { _Pragma("unroll") for (int _i = 0; _i < 2; ++_i) \
        __builtin_amdgcn_global_load_lds((const unsigned*)((const char*)(gbase) + (voff)[_i]), (PG8_LAS unsigned*)(lds + (bufoff) + ldsw + _i * 8192), 16, 0, 0); } while (0)
#define PG8_STAGE_A(bufoff, gbase, h, nx) do { \
        __builtin_amdgcn_global_load_lds((const unsigned*)((const char*)(gbase) + ((nx) ? vAn[h][0] : vA[h][0])), (PG8_LAS unsigned*)(lds + (bufoff) + ldsw), 16, 0, 0); \
        __builtin_amdgcn_global_load_lds((const unsigned*)((const char*)(gbase) + ((nx) ? vAn[h][1] : vA[h][1])), (PG8_LAS unsigned*)(lds + (bufoff) + ldsw + 8192), 16, 0, 0); } while (0)
#define PG8_LDA(dst, b, h) do { _Pragma("unroll") for (int m = 0; m < 4; ++m) _Pragma("unroll") for (int k = 0; k < 2; ++k) dst[m][k] = *(const PG8_LAS bf16x8*)(lds + PG8_SA(b, h) + aoff + m * 2048 + k * 1024); } while (0)
#define PG8_LDB(dst, b, h) do { _Pragma("unroll") for (int n = 0; n < 2; ++n) _Pragma("unroll") for (int k = 0; k < 2; ++k) dst[n][k] = *(const PG8_LAS bf16x8*)(lds + PG8_SB(b, h) + boff + n * 2048 + k * 1024); } while (0)
#define PG8_MMA(ai, bj, At, Bt) do { __builtin_amdgcn_s_setprio(1); _Pragma("unroll") for (int m = 0; m < 4; ++m) _Pragma("unroll") for (int n = 0; n < 2; ++n) _Pragma("unroll") for (int k = 0; k < 2; ++k) \
        acc[ai][bj][m][n] = __builtin_amdgcn_mfma_f32_16x16x32_bf16(Bt[n][k], At[m][k], acc[ai][bj][m][n], 0, 0, 0); __builtin_amdgcn_s_setprio(0); } while (0)
#define PG8_WAIT_V(n) asm volatile("s_waitcnt vmcnt(" #n ")" ::: "memory")
#define PG8_WAIT_L(n) asm volatile("s_waitcnt lgkmcnt(" #n ")" ::: "memory")
#define PG8_BAR __builtin_amdgcn_s_barrier()
#define PG8_SCHED __builtin_amdgcn_sched_barrier(0)
#define PG8_GATHER_OFFS(dst, u) do { if constexpr (GATHER) { _Pragma("unroll") for (int _h = 0; _h < 2; ++_h) _Pragma("unroll") for (int _i = 0; _i < 2; ++_i) \
        { int _R, _C; stage_rc(tid * 16 + _i * 8192, _R, _C); const int _r = _h * HALF + _R; const int _tok = (_r < (u).pad) ? (u).arow[_r] : 0; dst[_h][_i] = (unsigned)_tok * (unsigned)lda_b + (unsigned)(_C * 2); } } } while (0)
    Unit cur, nxt; int ui = 0;
    if (!S.next(0, cur)) return;
    acc_t acc;
#pragma unroll
    for (int a = 0; a < 2; ++a)
#pragma unroll
        for (int b = 0; b < 2; ++b)
#pragma unroll
            for (int m = 0; m < 4; ++m)
#pragma unroll
                for (int n = 0; n < 2; ++n) acc[a][b][m][n] = (f32x4){0.f, 0.f, 0.f, 0.f};
    bf16x8 At[4][2], B0[2][2], B1[2][2];
    const char* cA = cur.abase; const char* cB = cur.bbase;
    PG8_GATHER_OFFS(vA, cur);
    PG8_STAGE(PG8_SB(0, 0), cB, voffB); PG8_STAGE(PG8_SB(0, 1), cB + hstepB, voffB); PG8_STAGE_A(PG8_SA(0, 0), cA, 0, false); PG8_STAGE_A(PG8_SA(0, 1), cA, 1, false);
    if (wr == 1) PG8_BAR;
    PG8_WAIT_V(2); PG8_BAR;
    PG8_STAGE(PG8_SB(1, 0), cB + kstep, voffB); PG8_STAGE_A(PG8_SA(1, 0), cA + kstep, 0, false); PG8_STAGE(PG8_SB(1, 1), cB + hstepB + kstep, voffB);
    PG8_WAIT_V(6); PG8_BAR;
    for (;;) {
        const bool has_next = S.next(ui + 1, nxt);
        const char* nA = has_next ? nxt.abase : cA; const char* nB = has_next ? nxt.bbase : cB;
        for (int t = 0; t < nt; t += 2) {
            const bool last = (t == nt - 2);
            const char* a1 = cA + (size_t)(t + 1) * kstep;
            const char* a2 = last ? nA : cA + (size_t)(t + 2) * kstep; const char* b2 = last ? nB : cB + (size_t)(t + 2) * kstep;
            const char* a3 = a2 + kstep; const char* b3 = b2 + kstep;
            const bool nx = GATHER ? last : false;
            if constexpr (GATHER) { if (last) { if (has_next) { PG8_GATHER_OFFS(vAn, nxt); } else {
#pragma unroll
                for (int h = 0; h < 2; ++h)
#pragma unroll
                    for (int i = 0; i < 2; ++i) vAn[h][i] = vA[h][i]; } } }
            PG8_LDB(B0, 0, 0); PG8_LDB(B1, 0, 1); PG8_SCHED; PG8_LDA(At, 0, 0); PG8_STAGE_A(PG8_SA(1, 1), a1, 1, false);
            PG8_WAIT_V(8); PG8_WAIT_L(0); PG8_BAR; PG8_MMA(0, 0, At, B0); PG8_MMA(0, 1, At, B1); PG8_BAR; PG8_SCHED;
            PG8_LDA(At, 0, 1); PG8_STAGE(PG8_SB(0, 0), b2, voffB); PG8_STAGE(PG8_SB(0, 1), b2 + hstepB, voffB); PG8_STAGE_A(PG8_SA(0, 0), a2, 0, nx);
            PG8_WAIT_V(8); PG8_WAIT_L(0); PG8_BAR; PG8_MMA(1, 0, At, B0); PG8_MMA(1, 1, At, B1); PG8_BAR; PG8_SCHED;
            PG8_LDB(B0, 1, 0); PG8_LDB(B1, 1, 1); PG8_SCHED; PG8_LDA(At, 1, 0); PG8_STAGE_A(PG8_SA(0, 1), a2, 1, nx);
            PG8_WAIT_V(8); PG8_WAIT_L(0); PG8_BAR; PG8_MMA(0, 0, At, B0); PG8_MMA(0, 1, At, B1); PG8_BAR; PG8_SCHED;
            PG8_LDA(At, 1, 1); PG8_STAGE(PG8_SB(1, 0), b3, voffB); PG8_STAGE(PG8_SB(1, 1), b3 + hstepB, voffB); PG8_STAGE_A(PG8_SA(1, 0), a3, 0, nx);
            PG8_WAIT_V(8); PG8_WAIT_L(0); PG8_BAR; PG8_MMA(1, 0, At, B0); PG8_MMA(1, 1, At, B1); PG8_BAR; PG8_SCHED;
        }
        if (wr == 0) PG8_BAR;
        E(acc, cur, wr, wc, fr, fq);
        if (!has_next) break;
        if constexpr (MIDHOOK) { const float kz = (cur.e != 0) ? 1.f : 0.f;
#pragma unroll
            for (int a = 0; a < 2; ++a)
#pragma unroll
                for (int b = 0; b < 2; ++b)
#pragma unroll
                    for (int m = 0; m < 4; ++m)
#pragma unroll
                        for (int n = 0; n < 2; ++n)
#pragma unroll
                            for (int j = 0; j < 4; ++j) asm volatile("v_mul_f32_e32 %0, %1, %0" : "+v"(acc[a][b][m][n][j]) : "v"(kz));
        } else {
#pragma unroll
            for (int a = 0; a < 2; ++a)
#pragma unroll
                for (int b = 0; b < 2; ++b)
#pragma unroll
                    for (int m = 0; m < 4; ++m)
#pragma unroll
                        for (int n = 0; n < 2; ++n) acc[a][b][m][n] = (f32x4){0.f, 0.f, 0.f, 0.f};
        }
        cur = nxt; cA = nA; cB = nB; ++ui;
        if constexpr (GATHER) {
#pragma unroll
            for (int h = 0; h < 2; ++h)
#pragma unroll
                for (int i = 0; i < 2; ++i) vA[h][i] = vAn[h][i]; }
        if (wr == 1) PG8_BAR;
    }
    PG8_WAIT_V(0);
    PG8_BAR;
#undef PG8_SA
#undef PG8_SB
#undef PG8_STAGE
#undef PG8_STAGE_A
#undef PG8_LDA
#undef PG8_LDB
#undef PG8_MMA
#undef PG8_WAIT_V
#undef PG8_WAIT_L
#undef PG8_BAR
#undef PG8_SCHED
#undef PG8_GATHER_OFFS
}
}
#define GAS __attribute__((address_space(1)))
#define LAS __attribute__((address_space(3)))
typedef GAS unsigned gu32;
#define RLX_AGENT __ATOMIC_RELAXED, __HIP_MEMORY_SCOPE_AGENT
#define LDS_WAIT() asm volatile("s_waitcnt lgkmcnt(0)" ::: "memory")
#define VM_WAIT() asm volatile("s_waitcnt vmcnt(0)" ::: "memory")

#define XB_TMO      128
#define XB_XCNT(j)  (256  + 64 * (j))
#define XB_XSUB(j)  (1280 + 64 * (j))
#define XB_XGEN(j)  (2304 + 64 * (j))
#define XB_TOP      3328
#define XB_TOPGEN   3392
#define XCD_BAR_WORDS 3456
#define XB_SPIN_CAP (1u << 20)

__device__ __forceinline__ unsigned xb_ld(unsigned* p)              { return __hip_atomic_load(p, __ATOMIC_RELAXED, __HIP_MEMORY_SCOPE_AGENT); }
__device__ __forceinline__ unsigned xb_add(unsigned* p, unsigned v) { return __hip_atomic_fetch_add(p, v, __ATOMIC_RELAXED, __HIP_MEMORY_SCOPE_AGENT); }
__device__ __forceinline__ unsigned xb_xcc_id() { return (unsigned)__builtin_amdgcn_s_getreg((3 << 11) | 20) & 0xFu; }
#define XB_SPIN(cond, bar) do { unsigned _sp = 0; while (cond) { __builtin_amdgcn_s_sleep(1); \
    if ((++_sp & 255u) == 0u) { if (xb_ld(&(bar)[XB_TMO])) break; if (_sp > XB_SPIN_CAP) { atomicAdd(&(bar)[XB_TMO], 1u); break; } } } } while (0)

struct XcdBarrier { unsigned* bar; unsigned x; volatile LAS unsigned* st; };

__device__ __forceinline__ XcdBarrier xcd_barrier_post(unsigned* bar, volatile LAS unsigned* st, bool thread0) {
    XcdBarrier b; b.bar = bar; b.x = xb_xcc_id(); b.st = st;
    if (thread0) (void)xb_add(&bar[XB_XCNT(b.x)], 1u);
    return b;
}
__device__ __forceinline__ void xcd_barrier_complete(unsigned* bar, unsigned x, unsigned& nloc, unsigned& nx) {
    const unsigned G = gridDim.x * gridDim.y * gridDim.z;
    unsigned sum, cnt, mine, sp = 0u;
    for (;;) {
        sum = 0u; cnt = 0u; mine = 0u;
#pragma unroll
        for (unsigned j = 0; j < 16; ++j) { const unsigned c = xb_ld(&bar[XB_XCNT(j)]); sum += c; cnt += (c > 0u) ? 1u : 0u; mine = (j == x) ? c : mine; }
        if (sum == G) break;
        __builtin_amdgcn_s_sleep(1);
        if ((++sp & 255u) == 0u) { if (xb_ld(&bar[XB_TMO])) break; if (sp > XB_SPIN_CAP) { atomicAdd(&bar[XB_TMO], 1u); break; } }
    }
    nloc = mine > 0u ? mine : 1u; nx = cnt > 0u ? cnt : 1u;
}
__device__ __forceinline__ void xcd_barrier(const XcdBarrier& b, int wave  ) {
    asm volatile("s_waitcnt vmcnt(0)" ::: "memory");
    __syncthreads();
    if (wave == 0 && __builtin_amdgcn_mbcnt_hi(~0u, __builtin_amdgcn_mbcnt_lo(~0u, 0u)) == 0u) {
        unsigned* bar = b.bar;
        __builtin_amdgcn_s_waitcnt(0);
        unsigned nloc = b.st[0], nx = b.st[1];
        if (nloc == 0u) { xcd_barrier_complete(bar, b.x, nloc, nx); b.st[0] = nloc; b.st[1] = nx; }
        const unsigned old = xb_add(&bar[XB_XSUB(b.x)], 1u);
        const unsigned gen = old / nloc;
        if (old + 1u == (gen + 1u) * nloc) {
            __builtin_amdgcn_fence(__ATOMIC_RELEASE, "agent");
            asm volatile("s_waitcnt vmcnt(0)" ::: "memory");
            const unsigned og = xb_add(&bar[XB_TOP], 1u);
            const unsigned tg = og / nx;
            if (og + 1u == (tg + 1u) * nx) xb_add(&bar[XB_TOPGEN], 1u);
            else XB_SPIN(xb_ld(&bar[XB_TOPGEN]) == tg, bar);
            __builtin_amdgcn_fence(__ATOMIC_ACQUIRE, "agent");
            xb_add(&bar[XB_XGEN(b.x)], 1u);
            asm volatile("s_waitcnt vmcnt(0)" ::: "memory");
        } else {
            XB_SPIN(xb_ld(&bar[XB_XGEN(b.x)]) == gen, bar);
            __builtin_amdgcn_fence(__ATOMIC_ACQUIRE, "agent");
            asm volatile("s_waitcnt vmcnt(0)" ::: "memory");
        }
    }
    __syncthreads();
}

constexpr int RING_BYTES = 131072;
constexpr int LDSCTL_OFF = RING_BYTES, MISC_OFF = LDSCTL_OFF + 320;
constexpr int LDS_BYTES = 147456;
constexpr int NWAVES = 8;
constexpr int CW_BAR = 4096;
static_assert((CW_BAR + XCD_BAR_WORDS) * 4 <= (int)(1 * MiB), "CTL");

__device__ __forceinline__ float wsum(float v) {
#pragma unroll
    for (int o = 1; o < 64; o <<= 1) v += __shfl_xor(v, o);
    return v;
}
__device__ __forceinline__ float wmaxf(float v) {
#pragma unroll
    for (int o = 1; o < 64; o <<= 1) v = fmaxf(v, __shfl_xor(v, o));
    return v;
}
__device__ __forceinline__ float sigm(float x) { return 1.f / (1.f + __expf(-x)); }

using pg8::acc_t; using pg8::Unit; using pg8::HALF; using pg8::BM; using pg8::cvt_pk_bf16;

struct EpIn {
    static constexpr bool PERM = true;
    const float* b_in; bf16_t* ZA; bf16_t* ZB; bf16_t* ZG;
    __device__ __forceinline__ void operator()(acc_t& acc, const Unit& u, int wr, int wc, int fr, int fq) const {
        const int colt = u.pn * BM; bf16_t* base; int ldc, c0, boff;
        if (colt < 4096) { base = ZA; ldc = 4096; c0 = colt; boff = 0; } else if (colt < 7168) { base = ZB; ldc = 3072; c0 = colt - 4096; boff = 8; } else { base = ZG; ldc = 4096; c0 = colt - 7168; boff = 8; }
        const int row0 = u.pm * BM + wr * 64 + fr, cl = wc * 32 + 8 * fq;
        f32x4 bv[2][2];
#pragma unroll
        for (int bj = 0; bj < 2; ++bj)
#pragma unroll
            for (int n = 0; n < 2; ++n) bv[bj][n] = *(const f32x4*)(b_in + colt + boff + cl + bj * HALF + 4 * n);
#pragma unroll
        for (int ai = 0; ai < 2; ++ai)
#pragma unroll
            for (int m = 0; m < 4; ++m) { bf16_t* rowp = base + (size_t)(row0 + ai * HALF + m * 16) * ldc + c0 + cl;
#pragma unroll
                for (int bj = 0; bj < 2; ++bj) { const f32x4 v0 = acc[ai][bj][m][0] + bv[bj][0], v1 = acc[ai][bj][m][1] + bv[bj][1];
                    u32x4 w; w.x = cvt_pk_bf16(v0[0], v0[1]); w.y = cvt_pk_bf16(v0[2], v0[3]); w.z = cvt_pk_bf16(v1[0], v1[1]); w.w = cvt_pk_bf16(v1[2], v1[3]);
                    *(u32x4*)(rowp + bj * HALF) = w; } }
    }
};
__device__ __forceinline__ void unpack8(const u32x4 w, float (&f)[8]) {
    f[0] = __uint_as_float(w.x << 16); f[1] = __uint_as_float(w.x & 0xffff0000u); f[2] = __uint_as_float(w.y << 16); f[3] = __uint_as_float(w.y & 0xffff0000u);
    f[4] = __uint_as_float(w.z << 16); f[5] = __uint_as_float(w.z & 0xffff0000u); f[6] = __uint_as_float(w.w << 16); f[7] = __uint_as_float(w.w & 0xffff0000u);
}
struct EpMerge {
    static constexpr bool PERM = true;
    const bf16_t* ZG; bf16_t* MG;
    __device__ __forceinline__ void operator()(acc_t& acc, const Unit& u, int wr, int wc, int fr, int fq) const {
        const int row0 = u.pm * BM + wr * 64 + fr, col0 = u.pn * BM + wc * 32 + 8 * fq; const bool first = u.e != 0;
#pragma unroll
        for (int ai = 0; ai < 2; ++ai)
#pragma unroll
            for (int m = 0; m < 4; ++m) { const size_t r = (size_t)(row0 + ai * HALF + m * 16); const bf16_t* gp = ZG + r * 4096 + col0;
#pragma unroll
                for (int bj = 0; bj < 2; ++bj) { float ga[8], gb[8], o[8]; unpack8(*(const u32x4*)(gp + bj * HALF), ga); unpack8(*(const u32x4*)(gp + 2048 + bj * HALF), gb);
#pragma unroll
                    for (int j = 0; j < 8; ++j) { const float ea = 1.f + __expf(-ga[j]), eb = 1.f + __expf(-gb[j]); const float mul = first ? ea * __builtin_amdgcn_rcpf(eb) : 1.f;
                        asm volatile("v_mul_f32_e32 %0, %1, %0" : "+v"(acc[ai][bj][m][j >> 2][j & 3]) : "v"(mul)); o[j] = acc[ai][bj][m][j >> 2][j & 3] * __builtin_amdgcn_rcpf(ea); }
                    if (!first) { u32x4 w; w.x = cvt_pk_bf16(o[0], o[1]); w.y = cvt_pk_bf16(o[2], o[3]); w.z = cvt_pk_bf16(o[4], o[5]); w.w = cvt_pk_bf16(o[6], o[7]);
                        *(u32x4*)(MG + r * DM + col0 + bj * HALF) = w; } }
                __builtin_amdgcn_sched_barrier(0); }
    }
};
struct EpOutR {
    static constexpr bool PERM = true;
    const float* x; bf16_t* R; float* stats;
    __device__ __forceinline__ void operator()(acc_t& acc, const Unit& u, int wr, int wc, int fr, int fq) const {
        const int row0 = u.pm * BM + wr * 64 + fr, col0 = u.pn * BM + wc * 32 + 8 * fq;
#pragma unroll
        for (int ai = 0; ai < 2; ++ai)
#pragma unroll
            for (int m = 0; m < 4; ++m) { const int row = row0 + ai * HALF + m * 16; const size_t off = (size_t)row * DM + col0; float s = 0.f, q = 0.f;
#pragma unroll
                for (int bj = 0; bj < 2; ++bj) { const f32x4 x0 = *(const f32x4*)(x + off + bj * HALF), x1 = *(const f32x4*)(x + off + bj * HALF + 4);
                    const f32x4 v0 = x0 * ALPHA + acc[ai][bj][m][0], v1 = x1 * ALPHA + acc[ai][bj][m][1];
                    u32x4 w; w.x = cvt_pk_bf16(v0[0], v0[1]); w.y = cvt_pk_bf16(v0[2], v0[3]); w.z = cvt_pk_bf16(v1[0], v1[1]); w.w = cvt_pk_bf16(v1[2], v1[3]);
                    *(u32x4*)(R + off + bj * HALF) = w;
                    s += ((v0[0] + v0[1]) + (v0[2] + v0[3])) + ((v1[0] + v1[1]) + (v1[2] + v1[3]));
                    q += ((v0[0] * v0[0] + v0[1] * v0[1]) + (v0[2] * v0[2] + v0[3] * v0[3])) + ((v1[0] * v1[0] + v1[1] * v1[1]) + (v1[2] * v1[2] + v1[3] * v1[3])); }
                s += __shfl_xor(s, 16); s += __shfl_xor(s, 32); q += __shfl_xor(q, 16); q += __shfl_xor(q, 32);
                if (fq == 0) { atomicAdd(stats + 2 * row, s); atomicAdd(stats + 2 * row + 1, q); } }
    }
};
struct EpUp {
    static constexpr bool PERM = true;
    bf16_t* H;
    __device__ __forceinline__ void operator()(acc_t& acc, const Unit& u, int wr, int wc, int fr, int fq) const {
        const int row0 = u.pm * BM + wr * 64 + fr, col0 = u.pn * 128 + wc * 32 + 8 * fq;
#pragma unroll
        for (int ai = 0; ai < 2; ++ai)
#pragma unroll
            for (int m = 0; m < 4; ++m) { float o[8];
#pragma unroll
                for (int j = 0; j < 8; ++j) { const float g = acc[ai][0][m][j >> 2][j & 3], up = acc[ai][1][m][j >> 2][j & 3]; o[j] = g * __builtin_amdgcn_rcpf(1.f + __expf(-g)) * up; }
                u32x4 w; w.x = cvt_pk_bf16(o[0], o[1]); w.y = cvt_pk_bf16(o[2], o[3]); w.z = cvt_pk_bf16(o[4], o[5]); w.w = cvt_pk_bf16(o[6], o[7]);
                *(u32x4*)(H + (size_t)(row0 + ai * HALF + m * 16) * DE + col0) = w; }
    }
};
struct EpDown {
    static constexpr bool PERM = true;
    bf16_t* Y;
    __device__ __forceinline__ void operator()(acc_t& acc, const Unit& u, int wr, int wc, int fr, int fq) const {
        const int row0 = u.pm * BM + wr * 64 + fr, col0 = u.pn * BM + wc * 32 + 8 * fq;
#pragma unroll
        for (int ai = 0; ai < 2; ++ai)
#pragma unroll
            for (int m = 0; m < 4; ++m) { bf16_t* rowp = Y + (size_t)(row0 + ai * HALF + m * 16) * DM + col0;
#pragma unroll
                for (int bj = 0; bj < 2; ++bj) { const f32x4 v0 = acc[ai][bj][m][0], v1 = acc[ai][bj][m][1];
                    u32x4 w; w.x = cvt_pk_bf16(v0[0], v0[1]); w.y = cvt_pk_bf16(v0[2], v0[3]); w.z = cvt_pk_bf16(v1[0], v1[1]); w.w = cvt_pk_bf16(v1[2], v1[3]);
                    *(u32x4*)(rowp + bj * HALF) = w; } }
    }
};

struct MoeOrder {
    const LAS int* base;
    const int* cnt; const int* list; int ncol, G, c, gather; const char* A; const char* W; size_t estride, a_tstep, w_tstep;
    __device__ bool next(int i, Unit& u) const {
        const int ntile = base[NEXP] >> 8; const long L = (long)i * G + c; if (L >= (long)ntile * ncol) return false;
        const int rt = (int)(L / ncol), pn = (int)(L % ncol);
        int e = 0; while (e < NEXP - 1 && base[e + 1] <= rt * 256) ++e;
        u.pm = rt; u.pn = pn; u.e = e; const int r0 = rt * 256 - base[e];
        u.pad = cnt[e] - r0;
        u.arow = list + (size_t)e * T_TOK + r0;
        u.abase = gather ? A : A + (size_t)rt * a_tstep; u.bbase = W + (size_t)e * estride + (size_t)pn * w_tstep; return true;
    }
};
struct Args { const float* in[25]; float* out; unsigned char* ws; int ph_lo, ph_hi, li, pad; };
static_assert(sizeof(Args) == 27 * 8 + 16, "Args has no padding");

struct Frame {
    LAS unsigned char* lds; volatile LAS unsigned* MISC; unsigned* ctl;
    int tid, lane, wave, vcu, G;
};

__device__ __forceinline__ void transpose_item(const float* W, int ldw, int k0, int nsrc0, bf16_t* WT, size_t dst_row0, int ldt, int dst_k0, LAS float* scr, int lane) {
    float tv[32];
    { const float* wp = W + (size_t)(k0 + (lane >> 5)) * ldw + nsrc0 + (lane & 31);
#pragma unroll
        for (int i = 0; i < 32; ++i) tv[i] = wp[(size_t)(2 * i) * ldw];
#pragma unroll
        for (int i = 0; i < 32; ++i) scr[(2 * i + (lane >> 5)) * 33 + (lane & 31)] = tv[i]; }
    LDS_WAIT(); asm volatile("" ::: "memory");
    const int c = lane & 7;
#pragma unroll
    for (int j = 0; j < 4; ++j) { const int n = (lane >> 3) + 8 * j; const LAS float* s = scr + (8 * c) * 33 + n;
        u32x4 o; o.x = pk2(s[0 * 33], s[1 * 33]); o.y = pk2(s[2 * 33], s[3 * 33]); o.z = pk2(s[4 * 33], s[5 * 33]); o.w = pk2(s[6 * 33], s[7 * 33]);
        *(u32x4*)(WT + (dst_row0 + n) * ldt + dst_k0 + k0 + 8 * c) = o; }
    LDS_WAIT(); asm volatile("" ::: "memory");
}

__device__ __forceinline__ void p0_prologue(Frame& F, const Args& a) {
    unsigned char* ws = a.ws;
    const float* x = a.in[0]; const float* w_in = a.in[1]; const float* b_in = a.in[2]; const float* w_a = a.in[11]; const float* w_b = a.in[12]; const float* w_out = a.in[13];
    bf16_t* WIN_T = (bf16_t*)(ws + WS_WIN_T); bf16_t* WM_T = (bf16_t*)(ws + WS_WA_T); bf16_t* WOUT_T = (bf16_t*)(ws + WS_WOUT_T); bf16_t* XB = (bf16_t*)(ws + WS_XB); float* gates = (float*)(ws + WS_GATES);
    LAS float* scr = (LAS float*)(F.lds + F.wave * 8448);
    const int gw = F.vcu * NWAVES + F.wave, NGW = F.G * NWAVES;
    constexpr int I_IN = 32 * (N_MAIN / 32), I_B = 16 * 64, I_A = 16 * 64, I_O = 32 * 64;
    for (int it = gw; it < I_IN + I_B + I_A + I_O; it += NGW) {
        int r = it;
        if (r < I_IN) { const int kb = r / (N_MAIN / 32), nb = r % (N_MAIN / 32), n0 = nb * 32; transpose_item(w_in, N_IN, kb * 64, n0 + (n0 >= 4096 ? 8 : 0), WIN_T, n0, DM, 0, scr, F.lane); continue; } r -= I_IN;
        if (r < I_B) { const int kb = r / 64, nb = r % 64; transpose_item(w_b, DM, kb * 64, nb * 32, WM_T, nb * 32, DM, 0, scr, F.lane); continue; } r -= I_B;
        if (r < I_A) { const int kb = r / 64, nb = r % 64; transpose_item(w_a, DM, kb * 64, nb * 32, WM_T, nb * 32, DM, 1024, scr, F.lane); continue; } r -= I_A;
        { const int kb = r / 64, nb = r % 64; transpose_item(w_out, DM, kb * 64, nb * 32, WOUT_T, nb * 32, DM, 0, scr, F.lane); }
    }
    {
        const float* w_grp = a.in[16]; const float* w_exp = a.in[18]; bf16_t* WRH = (bf16_t*)(ws + WS_WRT); bf16_t* WRL = WRH + 48 * DM;
        for (int i = gw * 64 + F.lane; i < 48 * DM; i += NGW * 64) { const int n = i >> 11, k = i & (DM - 1);
            const float v = n < 4 ? w_grp[k * 4 + n] : (n < 36 ? w_exp[k * 32 + (n - 4)] : 0.f); const bf16_t hi = f2bf(v); WRH[i] = hi; WRL[i] = f2bf(v - bf2f(hi)); } }
    __syncthreads();
    LAS float* wgT = (LAS float*)F.lds;
    for (int i = F.tid; i < DM * 8; i += NWAVES * 64) { const int d = i >> 3, g = i & 7; wgT[g * DM + d] = w_in[(size_t)d * N_IN + 4096 + g]; }
    __syncthreads();
    for (int m = gw; m < T_TOK; m += NGW) {
        const float* xr = x + (size_t)m * DM; float acc[8];
#pragma unroll
        for (int g = 0; g < 8; ++g) acc[g] = 0.f;
#pragma unroll 2
        for (int i = 0; i < 8; ++i) { const int d0 = i * 256 + F.lane * 4; const f32x4 xv = *(const f32x4*)(xr + d0);
            u32x2 pk; pk.x = pk2(xv[0], xv[1]); pk.y = pk2(xv[2], xv[3]); *(u32x2*)(XB + (size_t)m * DM + d0) = pk;
#pragma unroll
            for (int g = 0; g < 8; ++g) { const f32x4 wv = *(const LAS f32x4*)(wgT + g * DM + d0); acc[g] += (xv[0] * wv[0] + xv[1] * wv[1]) + (xv[2] * wv[2] + xv[3] * wv[3]); } }
#pragma unroll
        for (int g = 0; g < 8; ++g) acc[g] = wsum(acc[g]);
        if (F.lane < 8) { float v = acc[0];
#pragma unroll
            for (int g = 1; g < 8; ++g) v = (F.lane == g) ? acc[g] : v;
            gates[(size_t)m * 8 + F.lane] = v + b_in[4096 + F.lane]; }
    }
}
__device__ __forceinline__ void moe_gu_copies(Frame& F, const Args& a) {
    unsigned char* ws = a.ws; const float* w_gate = a.in[20]; const float* w_up = a.in[21];
    bf16_t* WGU_T = (bf16_t*)(ws + WS_WGU_T);
    LAS float* scr = (LAS float*)(F.lds + F.wave * 8448);
    const int gw = F.vcu * NWAVES + F.wave, NGW = F.G * NWAVES;
    constexpr int I_G = NEXP * 32 * 16;
    for (int it = gw; it < 2 * I_G; it += NGW) { int r = it; const int up = r >= I_G; if (up) r -= I_G; const int e = r / 512, q = r % 512, kb = q / 16, nb = q % 16, n0 = nb * 32;
        transpose_item((up ? w_up : w_gate) + (size_t)e * DM * DE, DE, kb * 64, n0, WGU_T + (size_t)e * 1024 * DM, (n0 >> 7) * 256 + (n0 & 127) + (up ? 128 : 0), DM, 0, scr, F.lane); }
}
__device__ __forceinline__ void moe_down_copies_all(Frame& F, const Args& a) {
    unsigned char* ws = a.ws; const float* w_down = a.in[22]; bf16_t* WD_T = (bf16_t*)(ws + WS_WD_T);
    LAS float* scr = (LAS float*)(F.lds + F.wave * 8448);
    const int gw = F.vcu * NWAVES + F.wave, NGW = F.G * NWAVES;
    constexpr int I_D = NEXP * 8 * 64;
    for (int r = gw; r < I_D; r += NGW) { const int e = r / 512, q = r % 512, kb = q / 64, nb = q % 64;
        transpose_item(w_down + (size_t)e * DE * DM, DM, kb * 64, nb * 32, WD_T + (size_t)e * DM * DE, nb * 32, DE, 0, scr, F.lane); }
}

__device__ __forceinline__ void mlstm_rec_unit(Frame& F, const Args& a, int bh) {
    unsigned char* ws = a.ws; const bf16_t* ZA = (const bf16_t*)(ws + WS_ZA); const float* gates = (const float*)(ws + WS_GATES); bf16_t* HO = (bf16_t*)(ws + WS_XB);
    const float* conv_w = a.in[3]; const float* conv_b = a.in[4]; const float* norm_g = a.in[5];
    const int b = bh >> 2, h = bh & 3, tid = F.tid, j = tid & 255, kq = tid >> 8, lane = F.lane, wv = F.wave;
    LAS float* qs = (LAS float*)F.lds; LAS float* ks = qs + 256; LAS float* red = ks + 256; LAS float* sred = red + 512; LAS float* sred2 = sred + 8; LAS float* sred3 = sred2 + 8;
    float C[128];
#pragma unroll
    for (int i = 0; i < 128; ++i) C[i] = 0.f;
    float nreg = 0.f, m = 0.f;
    const int chan = (tid < 256) ? (h * 256 + tid) : (1024 + h * 256 + (tid - 256));
    const float cw0 = conv_w[chan], cw1 = conv_w[2048 + chan], cw2 = conv_w[4096 + chan], cw3 = conv_w[6144 + chan], cb = conv_b[chan];
    float z1 = 0, z2 = 0, z3 = 0;
    const float gch = norm_g[h * 256 + j];
    for (int t = 0; t < SEQ; ++t) {
        const size_t row = (size_t)b * SEQ + t;
        { const float zc = bf2f(ZA[row * 4096 + chan]); const float val = cw0 * z3 + cw1 * z2 + cw2 * z1 + cw3 * zc + cb; z3 = z2; z2 = z1; z1 = zc;
            const float s = val / (1.f + __expf(-val)); if (tid < 256) qs[tid] = s; else ks[tid - 256] = s * 0.0625f; }
        __syncthreads();
        const float ig = gates[row * 8 + h], fg = gates[row * 8 + 4 + h];
        const float lf = fminf(fg, 0.f) - log1pf(__expf(-fabsf(fg)));
        const float m_new = fmaxf(lf + m, ig), fd = __expf(lf + m - m_new), iw = __expf(ig - m_new); m = m_new;
        const float vj = bf2f(ZA[row * 4096 + 2048 + h * 256 + j]);
        float part = 0.f;
#pragma unroll
        for (int kk = 0; kk < 128; ++kk) { const int ki = kq * 128 + kk; C[kk] = fd * C[kk] + iw * ks[ki] * vj; part += qs[ki] * C[kk]; }
        red[kq * 256 + j] = part;
        float dpart = 0.f;
        if (tid < 256) { nreg = fd * nreg + iw * ks[tid]; dpart = qs[tid] * nreg; }
        dpart = wsum(dpart);
        if (tid < 256 && lane == 0) sred[wv] = dpart;
        __syncthreads();
        float hv = 0.f;
        if (tid < 256) { const float num = red[j] + red[256 + j]; const float den = sred[0] + sred[1] + sred[2] + sred[3];
            hv = sigm(bf2f(ZA[row * 4096 + 3072 + h * 256 + j])) * (num / fmaxf(fabsf(den), __expf(-m))); }
        const float s1 = wsum(hv);
        if (tid < 256 && lane == 0) sred2[wv] = s1;
        __syncthreads();
        const float mu = (sred2[0] + sred2[1] + sred2[2] + sred2[3]) * (1.f / 256.f);
        const float dv = (tid < 256) ? (hv - mu) : 0.f;
        const float s2 = wsum(dv * dv);
        if (tid < 256 && lane == 0) sred3[wv] = s2;
        __syncthreads();
        if (tid < 256) { const float var = (sred3[0] + sred3[1] + sred3[2] + sred3[3]) * (1.f / 256.f);
            HO[row * 2048 + 1024 + h * 256 + j] = f2bf(dv * rsqrtf(var + LN_EPS) * gch); }
    }
}
__device__ __forceinline__ void attn_simple_item(Frame& F, const Args& a, int idx, float lam) {
    unsigned char* ws = a.ws; const bf16_t* ZB = (const bf16_t*)(ws + WS_ZB); bf16_t* HO = (bf16_t*)(ws + WS_XB); const float* dng = a.in[10];
    const int lane = F.lane; LAS float* qs = (LAS float*)(F.lds + 8192) + F.wave * 128;
    const int t = idx & (SEQ - 1), h = (idx >> 12) & 7, b = idx >> 15;
    const size_t row = (size_t)b * SEQ + t;
    qs[lane] = bf2f(ZB[row * 3072 + h * 128 + lane]) * 0.125f;
    qs[64 + lane] = bf2f(ZB[row * 3072 + h * 128 + 64 + lane]) * 0.125f;
    LDS_WAIT(); asm volatile("" ::: "memory");
    const float slope = exp2f(-(float)(h + 1));
    const int kend = ((t >> 6) + 1) << 6;
    float m0 = -INFINITY, m1 = -INFINITY;
    for (int k0 = 0; k0 < kend; k0 += 64) {
        const int k = k0 + lane; const bf16_t* kp = ZB + ((size_t)b * SEQ + k) * 3072 + 1024 + h * 128;
        float s0 = 0.f, s1 = 0.f;
#pragma unroll 8
        for (int d = 0; d < 64; ++d) { s0 += qs[d] * bf2f(kp[d]); s1 += qs[64 + d] * bf2f(kp[64 + d]); }
        const float bias = slope * fabsf((float)(t - k)); s0 -= bias; s1 -= bias;
        m0 = fmaxf(m0, s0); m1 = fmaxf(m1, s1);
    }
    m0 = wmaxf(m0); m1 = wmaxf(m1);
    float l0 = 0.f, l1 = 0.f, a00 = 0.f, a01 = 0.f, a10 = 0.f, a11 = 0.f;
    for (int k0 = 0; k0 < kend; k0 += 64) {
        const int k = k0 + lane; const bf16_t* kp = ZB + ((size_t)b * SEQ + k) * 3072 + 1024 + h * 128;
        float s0 = 0.f, s1 = 0.f;
#pragma unroll 8
        for (int d = 0; d < 64; ++d) { s0 += qs[d] * bf2f(kp[d]); s1 += qs[64 + d] * bf2f(kp[64 + d]); }
        const float bias = slope * fabsf((float)(t - k)); s0 -= bias; s1 -= bias;
        const float p0 = __expf(s0 - m0), p1 = __expf(s1 - m1); l0 += p0; l1 += p1;
        for (int kk = 0; kk < 64; ++kk) { const float c0 = __shfl(p0, kk), c1 = __shfl(p1, kk);
            const bf16_t* vr = ZB + ((size_t)b * SEQ + k0 + kk) * 3072 + 2048 + h * 128;
            const float v0 = bf2f(vr[lane]), v1 = bf2f(vr[64 + lane]);
            a00 += c0 * v0; a01 += c0 * v1; a10 += c1 * v0; a11 += c1 * v1; }
    }
    l0 = wsum(l0); l1 = wsum(l1);
    const float olo = a00 / l0 - lam * a10 / l1, ohi = a01 / l0 - lam * a11 / l1;
    const float ms = wsum(olo * olo + ohi * ohi) * (1.f / 128.f);
    const float r = rsqrtf(ms + LN_EPS) * (1.f - LAMBDA_INIT);
    HO[row * 2048 + h * 128 + lane] = f2bf(olo * r * dng[lane]);
    HO[row * 2048 + h * 128 + 64 + lane] = f2bf(ohi * r * dng[64 + lane]);
    LDS_WAIT(); asm volatile("" ::: "memory");
}
constexpr int L1_STR = 528, L1_HI = 0, L1_LO = 64 * L1_STR, L1_ST = 2 * 64 * L1_STR, L1_PART = L1_ST + 1024, L1_END = L1_PART + 64 * 48 * 4;
static_assert(L1_END <= RING_BYTES, "LN1 unit LDS");
__device__ __forceinline__ void ln1_route_unit(Frame& F, const Args& a, int unit) {
    unsigned char* ws = a.ws; const bf16_t* R = (const bf16_t*)(ws + WS_R); bf16_t* X1B = (bf16_t*)(ws + WS_X1B);
    const float* g1 = a.in[14]; const float* b1 = a.in[15]; const float* b_grp = a.in[17]; const float* b_exp = a.in[19];
    const bf16_t* WRH = (const bf16_t*)(ws + WS_WRT); const bf16_t* WRL = WRH + 48 * DM;
    int* cnt = (int*)(ws + WS_CTL) + CW_CNT; int* list = (int*)(ws + WS_LIST); int* tok_e = (int*)(ws + WS_TOKE); int* tok_pos = (int*)(ws + WS_TOKP); float* tok_w = (float*)(ws + WS_TOKW);
    const int lane = F.lane, w = F.wave, tid = F.tid; LAS unsigned char* lds = F.lds;
    LAS float* sSt = (LAS float*)(lds + L1_ST);
    LAS float* sPart = (LAS float*)(lds + L1_PART);
    const int row0 = unit * 64;
    if (tid < 64) { const float* st = (const float*)(ws + WS_CTL) + CW_STATS + 2 * (row0 + tid); const float mu = st[0] * (1.f / DM); const float var = fmaxf(st[1] * (1.f / DM) - mu * mu, 0.f);
        sSt[2 * tid] = mu; sSt[2 * tid + 1] = rsqrtf(var + LN_EPS); }
    __syncthreads();
    const int mt = w & 3, kh = w >> 2;
    f32x4 acc[3]; acc[0] = (f32x4){0.f, 0.f, 0.f, 0.f}; acc[1] = acc[0]; acc[2] = acc[0];
    const int fo = (lane & 15) * L1_STR + 16 * (lane >> 4);
    u32x2 rv[8];
#pragma unroll
    for (int i = 0; i < 8; ++i) rv[i] = *(const u32x2*)(R + (size_t)(row0 + 8 * w + i) * DM + 4 * lane);
#pragma unroll 1
    for (int ch = 0; ch < 8; ++ch) {
        const int k0 = ch * 256 + 4 * lane; const f32x4 gg = *(const f32x4*)(g1 + k0), bb = *(const f32x4*)(b1 + k0);
        bf16x8 bh[4][3], bl[4][3];
#pragma unroll
        for (int kk = 0; kk < 4; ++kk)
#pragma unroll
            for (int nt = 0; nt < 3; ++nt) { const size_t wo = (size_t)(16 * nt + (lane & 15)) * DM + ch * 256 + 32 * (4 * kh + kk) + 8 * (lane >> 4);
                bh[kk][nt] = *(const bf16x8*)(WRH + wo); bl[kk][nt] = *(const bf16x8*)(WRL + wo); }
#pragma unroll
        for (int i = 0; i < 8; ++i) { const int r = 8 * w + i; const bf16_t* rr = R + (size_t)(row0 + r) * DM + k0; const float mu = sSt[2 * r], rstd = sSt[2 * r + 1];
            const f32x4 rf = (f32x4){__uint_as_float(rv[i].x << 16), __uint_as_float(rv[i].x & 0xffff0000u), __uint_as_float(rv[i].y << 16), __uint_as_float(rv[i].y & 0xffff0000u)};
            const f32x4 xv = (rf - mu) * rstd * gg + bb;
            if (ch < 7) rv[i] = *(const u32x2*)(rr + 256);
            u32x2 hi; hi.x = pk2(xv[0], xv[1]); hi.y = pk2(xv[2], xv[3]); *(u32x2*)(X1B + (size_t)(row0 + r) * DM + k0) = hi;
            u32x2 lo; lo.x = pk2(xv[0] - __uint_as_float(hi.x << 16), xv[1] - __uint_as_float(hi.x & 0xffff0000u)); lo.y = pk2(xv[2] - __uint_as_float(hi.y << 16), xv[3] - __uint_as_float(hi.y & 0xffff0000u));
            *(LAS u32x2*)(lds + L1_HI + r * L1_STR + 8 * lane) = hi; *(LAS u32x2*)(lds + L1_LO + r * L1_STR + 8 * lane) = lo; }
        __syncthreads();
#pragma unroll
        for (int kk = 0; kk < 4; ++kk) { const int ks = 4 * kh + kk;
            const bf16x8 ah = *(const LAS bf16x8*)(lds + L1_HI + 16 * mt * L1_STR + fo + 64 * ks), al = *(const LAS bf16x8*)(lds + L1_LO + 16 * mt * L1_STR + fo + 64 * ks);
#pragma unroll
            for (int nt = 0; nt < 3; ++nt) {
                acc[nt] = __builtin_amdgcn_mfma_f32_16x16x32_bf16(ah, bh[kk][nt], acc[nt], 0, 0, 0);
                acc[nt] = __builtin_amdgcn_mfma_f32_16x16x32_bf16(al, bh[kk][nt], acc[nt], 0, 0, 0);
                acc[nt] = __builtin_amdgcn_mfma_f32_16x16x32_bf16(ah, bl[kk][nt], acc[nt], 0, 0, 0); } }
        __syncthreads();
    }
    if (kh == 1) {
#pragma unroll
        for (int nt = 0; nt < 3; ++nt)
#pragma unroll
            for (int r = 0; r < 4; ++r) sPart[(16 * mt + 4 * (lane >> 4) + r) * 48 + 16 * nt + (lane & 15)] = acc[nt][r]; }
    __syncthreads();
    if (kh == 0) {
#pragma unroll
        for (int nt = 0; nt < 3; ++nt)
#pragma unroll
            for (int r = 0; r < 4; ++r) sPart[(16 * mt + 4 * (lane >> 4) + r) * 48 + 16 * nt + (lane & 15)] += acc[nt][r]; }
    __syncthreads();
    if (tid < 64) { const int row = row0 + tid; const LAS float* lg = sPart + tid * 48;
        float gl[4]; int gs = 0; float gm = -INFINITY;
#pragma unroll
        for (int c = 0; c < 4; ++c) { gl[c] = lg[c] + b_grp[c]; if (gl[c] > gm) { gm = gl[c]; gs = c; } }
        float den = 0.f;
#pragma unroll
        for (int c = 0; c < 4; ++c) den += __expf(gl[c] - gm);
        const float gp = 1.f / den;
        float v0 = -INFINITY, v1 = -INFINITY; int i0 = 0, i1 = 0;
#pragma unroll
        for (int j = 0; j < 8; ++j) { const int c = gs * 8 + j; const float val = lg[4 + c] + b_exp[c];
            if (val > v0) { v1 = v0; i1 = i0; v0 = val; i0 = c; } else if (val > v1) { v1 = val; i1 = c; } }
        const float w0 = 1.f / (1.f + __expf(v1 - v0)), w1 = 1.f - w0;
        const int p0 = atomicAdd(&cnt[i0], 1), p1 = atomicAdd(&cnt[i1], 1);
        list[i0 * T_TOK + p0] = row; list[i1 * T_TOK + p1] = row;
        tok_e[row * 2] = i0; tok_e[row * 2 + 1] = i1; tok_pos[row * 2] = p0; tok_pos[row * 2 + 1] = p1; tok_w[row * 2] = gp * w0; tok_w[row * 2 + 1] = gp * w1; }
    __syncthreads();
}
__device__ __forceinline__ void ln2_row(Frame& F, const Args& a, int row, const LAS int* base) {
    unsigned char* ws = a.ws; const bf16_t* X1 = (const bf16_t*)(ws + WS_R); const bf16_t* Y = (const bf16_t*)(ws + WS_Y);
    const int* tok_e = (const int*)(ws + WS_TOKE); const int* tok_pos = (const int*)(ws + WS_TOKP); const float* tok_w = (const float*)(ws + WS_TOKW);
    const float* g2 = a.in[23]; const float* b2 = a.in[24]; float* out = a.out; const int lane = F.lane;
    const size_t r0 = (size_t)(base[tok_e[row * 2]] + tok_pos[row * 2]) * DM, r1 = (size_t)(base[tok_e[row * 2 + 1]] + tok_pos[row * 2 + 1]) * DM;
    const float w0 = tok_w[row * 2], w1 = tok_w[row * 2 + 1];
    const float* g1 = a.in[14]; const float* b1 = a.in[15]; const float* st1 = (const float*)(ws + WS_CTL) + CW_STATS + 2 * row;
    const float mu1 = st1[0] * (1.f / DM), rstd1 = rsqrtf(fmaxf(st1[1] * (1.f / DM) - mu1 * mu1, 0.f) + LN_EPS);
    f32x4 v[8]; float s = 0.f;
#pragma unroll
    for (int i = 0; i < 8; ++i) { const int d0 = i * 256 + lane * 4; const u32x2 rw = *(const u32x2*)(X1 + (size_t)row * DM + d0);
        const f32x4 rf = (f32x4){__uint_as_float(rw.x << 16), __uint_as_float(rw.x & 0xffff0000u), __uint_as_float(rw.y << 16), __uint_as_float(rw.y & 0xffff0000u)};
        const f32x4 xv = (rf - mu1) * rstd1 * *(const f32x4*)(g1 + d0) + *(const f32x4*)(b1 + d0);
        const u32x2 y0 = *(const u32x2*)(Y + r0 + d0), y1 = *(const u32x2*)(Y + r1 + d0);
        f32x4 t;
        t[0] = ALPHA * xv[0] + w0 * __uint_as_float(y0.x << 16) + w1 * __uint_as_float(y1.x << 16);
        t[1] = ALPHA * xv[1] + w0 * __uint_as_float(y0.x & 0xffff0000u) + w1 * __uint_as_float(y1.x & 0xffff0000u);
        t[2] = ALPHA * xv[2] + w0 * __uint_as_float(y0.y << 16) + w1 * __uint_as_float(y1.y << 16);
        t[3] = ALPHA * xv[3] + w0 * __uint_as_float(y0.y & 0xffff0000u) + w1 * __uint_as_float(y1.y & 0xffff0000u);
        v[i] = t; s += (t[0] + t[1]) + (t[2] + t[3]); }
    const float mu = wsum(s) * (1.f / DM); float q = 0.f;
#pragma unroll
    for (int i = 0; i < 8; ++i) { v[i] = v[i] - mu; q += (v[i][0] * v[i][0] + v[i][1] * v[i][1]) + (v[i][2] * v[i][2] + v[i][3] * v[i][3]); }
    const float rstd = rsqrtf(wsum(q) * (1.f / DM) + LN_EPS);
#pragma unroll
    for (int i = 0; i < 8; ++i) { const int d0 = i * 256 + lane * 4; const f32x4 gg = *(const f32x4*)(g2 + d0), bb = *(const f32x4*)(b2 + d0);
        *(f32x4*)(out + (size_t)row * DM + d0) = v[i] * rstd * gg + bb; }
}
__device__ __forceinline__ void moe_base_to_lds(Frame& F, const Args& a, LAS int* base) {
    const int* cnt = (const int*)(a.ws + WS_CTL) + CW_CNT;
    if (F.tid == 0) { int acc = 0; for (int e = 0; e < NEXP; ++e) { base[e] = acc; acc += ((cnt[e] + 255) >> 8) << 8; } base[NEXP] = acc; }
    __syncthreads();
}
namespace att {
constexpr int KSTR = 256, VSTR = 256, KBYTES = 64 * KSTR, VBYTES = 64 * VSTR, BUF = KBYTES + VBYTES, NBUF = 4;
constexpr float LOG2E = 1.4426950408889634f;
typedef short v4i16_t __attribute__((ext_vector_type(4)));

__device__ __forceinline__ void unit(Frame& F, const Args& a, int b, int h, int qb, float lam, const LAS float* dngl  ) {
    unsigned char* ws = a.ws; const bf16_t* ZB = (const bf16_t*)(ws + WS_ZB); bf16_t* HO = (bf16_t*)(ws + WS_XB);
    const int tid = F.tid, lane = F.lane, w = F.wave, r32 = lane & 31, hi = lane >> 5, mp = w >> 2, wq = w & 3;
    LAS unsigned char* lds = F.lds;
    const int q0 = qb * 128 + wq * 32;
    const int qpos = q0 + r32;
    const int ntile = 2 * qb + 2;
    const int ntw = (q0 >> 6) + 1;
    const size_t rowb = (size_t)b * SEQ;
    const float slope = exp2f(-(float)(h + 1));
    bf16x8 qf[4];
    { const bf16_t* qp = ZB + (rowb + qpos) * 3072 + h * 128 + mp * 64 + 8 * hi;
#pragma unroll
        for (int ks = 0; ks < 4; ++ks) { const u32x4 raw = *(const u32x4*)(qp + 16 * ks); float f[8]; unpack8(raw, f);
            u32x4 o; o.x = pk2(f[0] * 0.125f, f[1] * 0.125f); o.y = pk2(f[2] * 0.125f, f[3] * 0.125f); o.z = pk2(f[4] * 0.125f, f[5] * 0.125f); o.w = pk2(f[6] * 0.125f, f[7] * 0.125f);
            qf[ks] = __builtin_bit_cast(bf16x8, o); } }
    unsigned gofs[4];
#pragma unroll
    for (int jj = 0; jj < 2; ++jj) { const int r = 8 * w + 4 * jj + (lane >> 4), cp = lane & 15;
        gofs[jj] = (unsigned)(((size_t)r * 3072 + 1024 + h * 128 + ((cp ^ (r & 15)) * 8)) * 2);
        gofs[2 + jj] = (unsigned)(((size_t)r * 3072 + 2048 + h * 128 + ((cp ^ ((r & 3) << 2)) * 8)) * 2); }
    const char* gtile = (const char*)(ZB + rowb * 3072);
#define ATT_GLDS(gp, ldst) do { unsigned _keep; asm volatile("s_mov_b32 %0, m0\n\ts_mov_b32 m0, %2\n\ts_nop 0\n\tglobal_load_lds_dwordx4 %1, off\n\ts_mov_b32 m0, %0" \
        : "=&s"(_keep) : "v"(gp), "s"(ldst) : "memory"); } while (0)
    const unsigned ldsb = (unsigned)(uintptr_t)lds + (unsigned)w * 2048u;
#define ATT_DMA(tt, bfi) do { const char* _g = gtile + (size_t)(tt) * (64 * 3072 * 2); const unsigned _l = (unsigned)__builtin_amdgcn_readfirstlane((int)(ldsb + (unsigned)(bfi) * BUF)); \
        ATT_GLDS(_g + gofs[0], _l); ATT_GLDS(_g + gofs[1], _l + 1024u); ATT_GLDS(_g + gofs[2], _l + (unsigned)KBYTES); ATT_GLDS(_g + gofs[3], _l + (unsigned)KBYTES + 1024u); } while (0)
    f32x16 oacc[4];
#pragma unroll
    for (int nb = 0; nb < 4; ++nb)
#pragma unroll
        for (int r = 0; r < 16; ++r) oacc[nb][r] = 0.f;
    const float sl4hi = slope * (float)(4 * hi);
    const float s32 = 32.f * slope;
    constexpr float THR = 6.0f;
    float m = -INFINITY, l = 0.f;
    const int krow = r32 * KSTR; int kx[4];
#pragma unroll
    for (int ks = 0; ks < 4; ++ks) kx[ks] = krow + (((mp * 8 + 2 * ks + hi) ^ (r32 & 15)) << 4);
    const int vq = (lane & 15) >> 2; int vo[4];
#pragma unroll
    for (int nb = 0; nb < 4; ++nb) vo[nb] = KBYTES + (4 * hi + vq) * VSTR + ((((nb ^ vq) << 2) + 2 * ((lane >> 4) & 1) + ((lane & 3) >> 1)) << 4) + (lane & 1) * 8;
#define ATT_TILE(seq) ((ntile - 1 - (seq)) > 0 ? (ntile - 1 - (seq)) : 0)
    ATT_DMA(ATT_TILE(0), 0); ATT_DMA(ATT_TILE(1), 1); ATT_DMA(ATT_TILE(2), 2);
    asm volatile("s_waitcnt vmcnt(8)\n\ts_barrier" ::: "memory");
    for (int it = 0; it < ntile; ++it) {
        const int t = ntile - 1 - it, bf = it & 3;
        ATT_DMA(ATT_TILE(it + 3), (it + 3) & 3);
        if (t < ntw && a.pad != 103) {
            LAS unsigned char* kb_ = lds + bf * BUF;
            f32x16 s0, s1;
            f32x16 bin;
            { float slo = slope; asm volatile("" : "+v"(slo));
#pragma unroll
                for (int r = 0; r < 16; ++r) bin[r] = slo * (float)((r & 3) + 8 * (r >> 2)) + sl4hi; }
            { bf16x8 kf0[2], kf1[2];
#pragma unroll
                for (int ks = 0; ks < 2; ++ks) { kf0[ks] = *(const LAS bf16x8*)(kb_ + kx[ks]); kf1[ks] = *(const LAS bf16x8*)(kb_ + kx[ks] + 32 * KSTR); }
                __builtin_amdgcn_sched_barrier(0);
                s0 = __builtin_amdgcn_mfma_f32_32x32x16_bf16(kf0[0], qf[0], bin, 0, 0, 0); s1 = __builtin_amdgcn_mfma_f32_32x32x16_bf16(kf1[0], qf[0], bin, 0, 0, 0);
                s0 = __builtin_amdgcn_mfma_f32_32x32x16_bf16(kf0[1], qf[1], s0, 0, 0, 0); s1 = __builtin_amdgcn_mfma_f32_32x32x16_bf16(kf1[1], qf[1], s1, 0, 0, 0);
                bf16x8 kg0[2], kg1[2];
#pragma unroll
                for (int ks = 0; ks < 2; ++ks) { kg0[ks] = *(const LAS bf16x8*)(kb_ + kx[ks + 2]); kg1[ks] = *(const LAS bf16x8*)(kb_ + kx[ks + 2] + 32 * KSTR); }
                s0 = __builtin_amdgcn_mfma_f32_32x32x16_bf16(kg0[0], qf[2], s0, 0, 0, 0); s1 = __builtin_amdgcn_mfma_f32_32x32x16_bf16(kg1[0], qf[2], s1, 0, 0, 0);
                s0 = __builtin_amdgcn_mfma_f32_32x32x16_bf16(kg0[1], qf[3], s0, 0, 0, 0); s1 = __builtin_amdgcn_mfma_f32_32x32x16_bf16(kg1[1], qf[3], s1, 0, 0, 0); }
            if (t == ntw - 1) {
                const float dq = (float)(qpos - t * 64); int hi4 = 4 * hi; asm volatile("" : "+v"(hi4));
#pragma unroll
                for (int r = 0; r < 16; ++r) { const float kk = (float)((r & 3) + 8 * (r >> 2) + hi4);
                    s0[r] += slope * (dq - fabsf(dq - kk) - kk); s1[r] += slope * (dq - fabsf(dq - (kk + 32.f)) - (kk + 32.f)); } }
            float mx0 = fmaxf(fmaxf(s0[0], s0[1]), s0[2]), mx1 = fmaxf(fmaxf(s1[0], s1[1]), s1[2]);
#pragma unroll
            for (int r = 3; r < 15; r += 2) { mx0 = fmaxf(fmaxf(mx0, s0[r]), s0[r + 1]); mx1 = fmaxf(fmaxf(mx1, s1[r]), s1[r + 1]); }
            mx0 = fmaxf(mx0, s0[15]); mx1 = fmaxf(mx1, s1[15]);
            const float ct = slope * (float)(t * 64);
            float mx = fmaxf(mx0, mx1 + s32) + ct;
            mx = fmaxf(mx, __shfl_xor(mx, 32));
            const bool dead = __all(mx - m < -104.f) || (a.pad == 102 && it > 0);
            if (!dead) {
            if (__any(mx > m + THR)) {
                const float m_new = fmaxf(m, mx); const float sc = __builtin_amdgcn_exp2f((m - m_new) * LOG2E); m = m_new; l *= sc;
#pragma unroll
                for (int nb = 0; nb < 4; ++nb)
#pragma unroll
                    for (int r = 0; r < 16; ++r) oacc[nb][r] *= sc;
            }
            const float c0 = (ct - m) * LOG2E, c1 = c0 + s32 * LOG2E;
            float ps = 0.f;
#pragma unroll
            for (int r = 0; r < 16; ++r) { s0[r] = __builtin_amdgcn_exp2f(s0[r] * LOG2E + c0); s1[r] = __builtin_amdgcn_exp2f(s1[r] * LOG2E + c1); ps += s0[r] + s1[r]; }
            l += ps;
            bf16x8 pf[2][2];
#pragma unroll
            for (int s = 0; s < 2; ++s) { u32x4 p0, p1;
                p0.x = cvt_pk_bf16(s0[8 * s + 0], s0[8 * s + 1]); p0.y = cvt_pk_bf16(s0[8 * s + 2], s0[8 * s + 3]); p0.z = cvt_pk_bf16(s0[8 * s + 4], s0[8 * s + 5]); p0.w = cvt_pk_bf16(s0[8 * s + 6], s0[8 * s + 7]);
                p1.x = cvt_pk_bf16(s1[8 * s + 0], s1[8 * s + 1]); p1.y = cvt_pk_bf16(s1[8 * s + 2], s1[8 * s + 3]); p1.z = cvt_pk_bf16(s1[8 * s + 4], s1[8 * s + 5]); p1.w = cvt_pk_bf16(s1[8 * s + 6], s1[8 * s + 7]);
                pf[0][s] = __builtin_bit_cast(bf16x8, p0); pf[1][s] = __builtin_bit_cast(bf16x8, p1); }
            { v4i16_t lo[2][4], hh[2][4];
#define ATT_VRD(set, g) do { _Pragma("unroll") for (int nb = 0; nb < 4; ++nb) { \
                    lo[set][nb] = __builtin_amdgcn_ds_read_tr16_b64_v4i16((LAS v4i16_t*)(kb_ + vo[nb] + ((g) * 16) * VSTR)); \
                    hh[set][nb] = __builtin_amdgcn_ds_read_tr16_b64_v4i16((LAS v4i16_t*)(kb_ + vo[nb] + ((g) * 16 + 8) * VSTR)); } } while (0)
#define ATT_PV(set, g) do { _Pragma("unroll") for (int nb = 0; nb < 4; ++nb) { \
                    const bf16x8 vf = (bf16x8){lo[set][nb][0], lo[set][nb][1], lo[set][nb][2], lo[set][nb][3], hh[set][nb][0], hh[set][nb][1], hh[set][nb][2], hh[set][nb][3]}; \
                    oacc[nb] = __builtin_amdgcn_mfma_f32_32x32x16_bf16(vf, pf[(g) >> 1][(g) & 1], oacc[nb], 0, 0, 0); } } while (0)
                ATT_VRD(0, 0); __builtin_amdgcn_sched_barrier(0);
                ATT_VRD(1, 1); __builtin_amdgcn_sched_barrier(0); ATT_PV(0, 0); __builtin_amdgcn_sched_barrier(0);
                ATT_VRD(0, 2); __builtin_amdgcn_sched_barrier(0); ATT_PV(1, 1); __builtin_amdgcn_sched_barrier(0);
                ATT_VRD(1, 3); __builtin_amdgcn_sched_barrier(0); ATT_PV(0, 2); __builtin_amdgcn_sched_barrier(0);
                ATT_PV(1, 3);
#undef ATT_VRD
#undef ATT_PV
            }
            }
        }
        asm volatile("s_waitcnt vmcnt(8) lgkmcnt(0)\n\ts_barrier" ::: "memory");
    }
    asm volatile("s_waitcnt vmcnt(0)\n\ts_barrier" ::: "memory");
#undef ATT_TILE
#undef ATT_DMA
#undef ATT_GLDS
    l += __shfl_xor(l, 32);
    const float inv = 1.f / l;
    LAS float* xb = (LAS float*)(lds + wq * 16384);
    if (mp == 1) {
#pragma unroll
        for (int nb = 0; nb < 4; ++nb)
#pragma unroll
            for (int r = 0; r < 16; ++r) xb[(nb * 16 + r) * 64 + lane] = oacc[nb][r] * inv;
    }
    __syncthreads();
    if (mp == 0) {
        float ss = 0.f;
#pragma unroll
        for (int nb = 0; nb < 4; ++nb) {
#pragma unroll
            for (int r = 0; r < 16; ++r) { const float o = oacc[nb][r] * inv - lam * xb[(nb * 16 + r) * 64 + lane]; oacc[nb][r] = o; ss += o * o; }
            __builtin_amdgcn_sched_barrier(0); }
        ss += __shfl_xor(ss, 32);
        const float rs = rsqrtf(ss * (1.f / 128.f) + LN_EPS) * (1.f - LAMBDA_INIT);
        bf16_t* op = HO + (rowb + qpos) * 2048 + h * 128 + 4 * hi;
#pragma unroll
        for (int nb = 0; nb < 4; ++nb)
#pragma unroll
            for (int g = 0; g < 4; ++g) { const int dv = nb * 32 + 8 * g; const f32x4 gg = *(const LAS f32x4*)(dngl + dv + 4 * hi);
                u32x2 o; o.x = pk2(oacc[nb][4 * g] * rs * gg[0], oacc[nb][4 * g + 1] * rs * gg[1]); o.y = pk2(oacc[nb][4 * g + 2] * rs * gg[2], oacc[nb][4 * g + 3] * rs * gg[3]);
                *(u32x2*)(op + dv) = o; }
    }
    __syncthreads();
}
}
namespace mls {
constexpr int KT_STR = 144;
constexpr int KT_BYTES = 256 * KT_STR;
constexpr int VTS_BYTES = 64 * KT_STR;
constexpr int SBUF = KT_BYTES + VTS_BYTES + 256;
constexpr size_t WS_MST = WS_SCAL;
constexpr size_t WS_NST = WS_SCAL + 65536;

__device__ __forceinline__ float silu_(float v) { return v * __builtin_amdgcn_rcpf(1.f + __expf(-v)); }
__device__ __forceinline__ float logsig_(float x) { return fminf(x, 0.f) - __logf(1.f + __expf(-fabsf(x))); }
__device__ __forceinline__ float lo16(unsigned u) { return __uint_as_float(u << 16); }
__device__ __forceinline__ float hi16(unsigned u) { return __uint_as_float(u & 0xffff0000u); }

__device__ __forceinline__ void chunk_scalars(const float ig, const float fg, int lane, float& bcs, float& a, float& cm) {
    float b = logsig_(fg);
#pragma unroll
    for (int o = 1; o < 64; o <<= 1) { const float t = __shfl_up(b, o); if (lane >= o) b += t; }
    a = ig - b; float c = a;
#pragma unroll
    for (int o = 1; o < 64; o <<= 1) { const float t = __shfl_up(c, o); if (lane >= o) c = fmaxf(c, t); }
    bcs = b; cm = c;
}

constexpr size_t WS_DNS = WS_SCAL + 65536;
constexpr size_t WS_AMX = WS_SCAL + 8192;
__device__ __forceinline__ void dc_unit(Frame& F, const Args& a_, int bh, int c) {
    unsigned char* ws = a_.ws; const bf16_t* ZA = (const bf16_t*)(ws + WS_ZA); const float* gates = (const float*)(ws + WS_GATES);
    bf16_t* CST = (bf16_t*)(ws + WS_CST); float* DNS = (float*)(ws + WS_DNS); float* AMX = (float*)(ws + WS_AMX);
    const float* conv_w = a_.in[3]; const float* conv_b = a_.in[4];
    const int b = bh >> 2, h = bh & 3, tid = F.tid, lane = F.lane, w = F.wave;
    const size_t rowb = (size_t)b * SEQ, row0 = rowb + (size_t)c * 64;
    LAS unsigned char* lds = F.lds;
    float bcs, av, cm; chunk_scalars(gates[(row0 + lane) * 8 + h], gates[(row0 + lane) * 8 + 4 + h], lane, bcs, av, cm);
    const float amax = __shfl(cm, 63), blast = __shfl(bcs, 63); const float wt = __expf(av - amax);
    if (tid == 0) { AMX[bh * 64 + c] = amax; AMX[1024 + bh * 64 + c] = blast; }
    { const int cp = tid & 127, sg = tid >> 7; const int kch = 1024 + h * 256 + 2 * cp;
        float cw[2][4], cb[2];
#pragma unroll
        for (int e = 0; e < 2; ++e) { cb[e] = conv_b[kch + e];
#pragma unroll
            for (int j = 0; j < 4; ++j) cw[e][j] = conv_w[j * 2048 + kch + e]; }
        unsigned kraw[19];
#pragma unroll
        for (int i = 0; i < 19; ++i) { const int t = c * 64 + 16 * sg - 3 + i; kraw[i] = (t >= 0) ? *(const unsigned*)(ZA + (rowb + t) * 4096 + kch) : 0u; }
        float o0[16], o1[16];
#pragma unroll
        for (int s = 0; s < 16; ++s) { const float ws_ = __shfl(wt, (16 * sg + s) & 63) * 0.0625f;
            const float v0 = cw[0][0] * lo16(kraw[s]) + cw[0][1] * lo16(kraw[s + 1]) + cw[0][2] * lo16(kraw[s + 2]) + cw[0][3] * lo16(kraw[s + 3]) + cb[0];
            const float v1 = cw[1][0] * hi16(kraw[s]) + cw[1][1] * hi16(kraw[s + 1]) + cw[1][2] * hi16(kraw[s + 2]) + cw[1][3] * hi16(kraw[s + 3]) + cb[1];
            o0[s] = silu_(v0) * ws_; o1[s] = silu_(v1) * ws_; }
        LAS unsigned char* p0 = lds + (2 * cp) * KT_STR + 32 * sg;
        u32x4 q;
        q.x = pk2(o0[0], o0[1]); q.y = pk2(o0[2], o0[3]); q.z = pk2(o0[4], o0[5]); q.w = pk2(o0[6], o0[7]); *(LAS u32x4*)p0 = q;
        q.x = pk2(o0[8], o0[9]); q.y = pk2(o0[10], o0[11]); q.z = pk2(o0[12], o0[13]); q.w = pk2(o0[14], o0[15]); *(LAS u32x4*)(p0 + 16) = q;
        q.x = pk2(o1[0], o1[1]); q.y = pk2(o1[2], o1[3]); q.z = pk2(o1[4], o1[5]); q.w = pk2(o1[6], o1[7]); *(LAS u32x4*)(p0 + KT_STR) = q;
        q.x = pk2(o1[8], o1[9]); q.y = pk2(o1[10], o1[11]); q.z = pk2(o1[12], o1[13]); q.w = pk2(o1[14], o1[15]); *(LAS u32x4*)(p0 + KT_STR + 16) = q; }
#pragma unroll
    for (int it = 0; it < 2; ++it) { const int item = tid + 512 * it, vp = item & 127, vg = item >> 7;
        unsigned r[8];
#pragma unroll
        for (int i = 0; i < 8; ++i) r[i] = *(const unsigned*)(ZA + (row0 + 8 * vg + i) * 4096 + 2048 + h * 256 + 2 * vp);
        u32x4 q0, q1;
        q0.x = (r[0] & 0xffffu) | (r[1] << 16); q0.y = (r[2] & 0xffffu) | (r[3] << 16); q0.z = (r[4] & 0xffffu) | (r[5] << 16); q0.w = (r[6] & 0xffffu) | (r[7] << 16);
        q1.x = (r[0] >> 16) | (r[1] & 0xffff0000u); q1.y = (r[2] >> 16) | (r[3] & 0xffff0000u); q1.z = (r[4] >> 16) | (r[5] & 0xffff0000u); q1.w = (r[6] >> 16) | (r[7] & 0xffff0000u);
        *(LAS u32x4*)(lds + KT_BYTES + (2 * vp) * KT_STR + 16 * vg) = q0; *(LAS u32x4*)(lds + KT_BYTES + (2 * vp + 1) * KT_STR + 16 * vg) = q1; }
    __syncthreads();
    if (tid < 256) { const LAS unsigned char* kr = lds + tid * KT_STR; float sacc = 0.f;
#pragma unroll
        for (int j = 0; j < 8; ++j) { float f[8]; unpack8(*(const LAS u32x4*)(kr + 16 * j), f); sacc += ((f[0] + f[1]) + (f[2] + f[3])) + ((f[4] + f[5]) + (f[6] + f[7])); }
        DNS[(size_t)(bh * 64 + c) * 256 + tid] = sacc; }
    { const int fo = (lane & 15) * KT_STR + 16 * (lane >> 4);
        bf16x8 A[2][2];
#pragma unroll
        for (int mt = 0; mt < 2; ++mt)
#pragma unroll
            for (int ks = 0; ks < 2; ++ks) A[mt][ks] = *(const LAS bf16x8*)(lds + (32 * w + 16 * mt) * KT_STR + fo + 64 * ks);
        bf16_t* cbase = CST + (size_t)(bh * 64 + c) * 65536 + 32 * w + 4 * (lane >> 4);
#pragma unroll
        for (int ng = 0; ng < 4; ++ng) {
            bf16x8 B[4][2];
#pragma unroll
            for (int nt = 0; nt < 4; ++nt)
#pragma unroll
                for (int ks = 0; ks < 2; ++ks) B[nt][ks] = *(const LAS bf16x8*)(lds + KT_BYTES + (64 * ng + 16 * nt) * KT_STR + fo + 64 * ks);
#pragma unroll
            for (int mt = 0; mt < 2; ++mt)
#pragma unroll
                for (int nt = 0; nt < 4; ++nt) { f32x4 acc = (f32x4){0.f, 0.f, 0.f, 0.f};
#pragma unroll
                    for (int ks = 0; ks < 2; ++ks) acc = __builtin_amdgcn_mfma_f32_16x16x32_bf16(A[mt][ks], B[nt][ks], acc, 0, 0, 0);
                    u32x2 q; q.x = pk2(acc[0], acc[1]); q.y = pk2(acc[2], acc[3]);
                    *(u32x2*)(cbase + (size_t)(64 * ng + 16 * nt + (lane & 15)) * 256 + 16 * mt) = q; } } }
    __syncthreads();
}

__device__ __forceinline__ void scan_item(Frame& F, const Args& a_, int bh, int part) {
    unsigned char* ws = a_.ws; bf16_t* CST = (bf16_t*)(ws + WS_CST); float* DNS = (float*)(ws + WS_DNS); const float* AMX = (const float*)(ws + WS_AMX); float* MST = (float*)(ws + WS_MST);
    const int tid = F.tid;
    LAS float* tb = (LAS float*)(F.lds);
    if (tid < 128) tb[tid] = AMX[(tid >> 6) * 1024 + bh * 64 + (tid & 63)];
    __syncthreads();
    u32x4* p = (u32x4*)(CST + (size_t)bh * 64 * 65536 + (size_t)part * 4096 + tid * 8);
    float st[8]; float nst = 0.f, m = 0.f;
#pragma unroll
    for (int e = 0; e < 8; ++e) st[e] = 0.f;
    const bool do_n = (part == 0) && (tid < 256);
    float* pn = DNS + (size_t)bh * 64 * 256 + tid;
    u32x4 d[8]; float dn[8];
#pragma unroll
    for (int i = 0; i < 8; ++i) { d[i] = p[(size_t)i * 8192]; dn[i] = do_n ? pn[i * 256] : 0.f; }
#pragma unroll 8
    for (int c = 0; c < 64; ++c) {
        const u32x4 dc = d[c & 7]; const float dnc = dn[c & 7];
        u32x4 o; o.x = pk2(st[0], st[1]); o.y = pk2(st[2], st[3]); o.z = pk2(st[4], st[5]); o.w = pk2(st[6], st[7]);
        p[(size_t)c * 8192] = o;
        if (do_n) pn[c * 256] = nst;
        if (part == 0 && tid == 0) MST[bh * 64 + c] = m;
        if (c + 8 < 64) { d[c & 7] = p[(size_t)(c + 8) * 8192]; dn[c & 7] = do_n ? pn[(c + 8) * 256] : 0.f; }
        const float amax = tb[c], Mx = fmaxf(m, amax), decay = __expf(m - Mx), g = __expf(amax - Mx);
        float f[8]; unpack8(dc, f);
#pragma unroll
        for (int e = 0; e < 8; ++e) st[e] = decay * st[e] + g * f[e];
        nst = decay * nst + g * dnc;
        m = tb[64 + c] + Mx;
    }
    __syncthreads();
}

constexpr int QSTR = 528;
constexpr int O_Q = 0, O_K = 64 * QSTR, O_VT = 2 * 64 * QSTR, O_P = O_VT + 256 * KT_STR, O_SC = O_P + 64 * KT_STR;
constexpr int O_END = O_SC + 4096;
static_assert(O_END <= RING_BYTES, "mLSTM output unit LDS");
__device__ __forceinline__ void out_unit(Frame& F, const Args& a_, int bh, int c) {
    unsigned char* ws = a_.ws; const bf16_t* ZA = (const bf16_t*)(ws + WS_ZA); const float* gates = (const float*)(ws + WS_GATES);
    const bf16_t* CST = (const bf16_t*)(ws + WS_CST); const float* MST = (const float*)(ws + WS_MST); const float* NST = (const float*)(ws + WS_NST); bf16_t* HO = (bf16_t*)(ws + WS_XB);
    const float* conv_w = a_.in[3]; const float* conv_b = a_.in[4]; const float* norm_g = a_.in[5];
    const int b = bh >> 2, h = bh & 3, tid = F.tid, lane = F.lane, w = F.wave;
    const size_t row0 = (size_t)b * SEQ + (size_t)c * 64;
    LAS unsigned char* lds = F.lds;
    LAS float* SC = (LAS float*)(lds + O_SC);
    LAS float* sA = SC, *sM = SC + 64, *sWi = SC + 128, *sEf = SC + 192, *sQn = SC + 256, *sRs = SC + 320, *sSt = SC + 448;
    const float m0 = MST[bh * 64 + c];
    if (w == 0) { float bcs, av, cm; chunk_scalars(gates[(row0 + lane) * 8 + h], gates[(row0 + lane) * 8 + 4 + h], lane, bcs, av, cm); const float M = fmaxf(m0, cm);
        sA[lane] = av; sM[lane] = M; sWi[lane] = __expf(m0 - M); sEf[lane] = __expf(-(bcs + M)); }
    { const int cg = tid & 31, pg = tid >> 5;
#pragma unroll
        for (int mat = 0; mat < 2; ++mat) {
            const int ch0 = mat * 1024 + h * 256 + 8 * cg;
            float cwv[4][8], cbv[8];
#pragma unroll
            for (int j = 0; j < 4; ++j) { const f32x4 x0 = *(const f32x4*)(conv_w + j * 2048 + ch0), x1 = *(const f32x4*)(conv_w + j * 2048 + ch0 + 4);
                cwv[j][0] = x0[0]; cwv[j][1] = x0[1]; cwv[j][2] = x0[2]; cwv[j][3] = x0[3]; cwv[j][4] = x1[0]; cwv[j][5] = x1[1]; cwv[j][6] = x1[2]; cwv[j][7] = x1[3]; }
            { const f32x4 x0 = *(const f32x4*)(conv_b + ch0), x1 = *(const f32x4*)(conv_b + ch0 + 4);
                cbv[0] = x0[0]; cbv[1] = x0[1]; cbv[2] = x0[2]; cbv[3] = x0[3]; cbv[4] = x1[0]; cbv[5] = x1[1]; cbv[6] = x1[2]; cbv[7] = x1[3]; }
            float z[7][8];
#pragma unroll
            for (int i = 0; i < 7; ++i) { const int t = c * 64 + 4 * pg - 3 + i;
                if (t >= 0) { unpack8(*(const u32x4*)(ZA + ((size_t)b * SEQ + t) * 4096 + ch0), z[i]); } else {
#pragma unroll
                    for (int e = 0; e < 8; ++e) z[i][e] = 0.f; } }
            const float scl = mat ? 0.0625f : 1.f;
#pragma unroll
            for (int s = 0; s < 4; ++s) { float o[8];
#pragma unroll
                for (int e = 0; e < 8; ++e) o[e] = silu_(cwv[0][e] * z[s][e] + cwv[1][e] * z[s + 1][e] + cwv[2][e] * z[s + 2][e] + cwv[3][e] * z[s + 3][e] + cbv[e]) * scl;
                u32x4 q; q.x = pk2(o[0], o[1]); q.y = pk2(o[2], o[3]); q.z = pk2(o[4], o[5]); q.w = pk2(o[6], o[7]);
                *(LAS u32x4*)(lds + (mat ? O_K : O_Q) + (4 * pg + s) * QSTR + 16 * cg) = q; }
        } }
#pragma unroll
    for (int it = 0; it < 2; ++it) { const int item = tid + 512 * it, vp = item & 127, vg = item >> 7;
        unsigned r[8];
#pragma unroll
        for (int i = 0; i < 8; ++i) r[i] = *(const unsigned*)(ZA + (row0 + 8 * vg + i) * 4096 + 2048 + h * 256 + 2 * vp);
        u32x4 q0, q1;
        q0.x = (r[0] & 0xffffu) | (r[1] << 16); q0.y = (r[2] & 0xffffu) | (r[3] << 16); q0.z = (r[4] & 0xffffu) | (r[5] << 16); q0.w = (r[6] & 0xffffu) | (r[7] << 16);
        q1.x = (r[0] >> 16) | (r[1] & 0xffff0000u); q1.y = (r[2] >> 16) | (r[3] & 0xffff0000u); q1.z = (r[4] >> 16) | (r[5] & 0xffff0000u); q1.w = (r[6] >> 16) | (r[7] & 0xffff0000u);
        *(LAS u32x4*)(lds + O_VT + (2 * vp) * KT_STR + 16 * vg) = q0; *(LAS u32x4*)(lds + O_VT + (2 * vp + 1) * KT_STR + 16 * vg) = q1; }
    __syncthreads();
    { const int mt = w >> 1; const int fo = (lane & 15) * QSTR + 16 * (lane >> 4);
        f32x4 s[2]; s[0] = (f32x4){0.f, 0.f, 0.f, 0.f}; s[1] = s[0];
#pragma unroll
        for (int ks = 0; ks < 8; ++ks) { const bf16x8 A = *(const LAS bf16x8*)(lds + O_Q + 16 * mt * QSTR + fo + 64 * ks);
#pragma unroll
            for (int j = 0; j < 2; ++j) { const int nt = (w & 1) * 2 + j; const bf16x8 B = *(const LAS bf16x8*)(lds + O_K + 16 * nt * QSTR + fo + 64 * ks);
                s[j] = __builtin_amdgcn_mfma_f32_16x16x32_bf16(A, B, s[j], 0, 0, 0); } }
        float rsum[4] = {0.f, 0.f, 0.f, 0.f};
#pragma unroll
        for (int j = 0; j < 2; ++j) { const int nt = (w & 1) * 2 + j, sp = 16 * nt + (lane & 15); const float as = sA[sp];
#pragma unroll
            for (int r = 0; r < 4; ++r) { const int t = 16 * mt + 4 * (lane >> 4) + r; const float d = (sp <= t) ? __expf(as - sM[t]) : 0.f; const float p = s[j][r] * d; rsum[r] += p;
                *(LAS bf16_t*)(lds + O_P + t * KT_STR + 2 * sp) = f2bf(p); } }
#pragma unroll
        for (int r = 0; r < 4; ++r) { float v = rsum[r]; v += __shfl_xor(v, 1); v += __shfl_xor(v, 2); v += __shfl_xor(v, 4); v += __shfl_xor(v, 8);
            if ((lane & 15) == 0) sRs[(16 * mt + 4 * (lane >> 4) + r) * 2 + (w & 1)] = v; }
        const f32x4 nv = *(const f32x4*)(NST + (size_t)(bh * 64 + c) * 256 + 4 * lane);
#pragma unroll
        for (int i = 0; i < 8; ++i) { const int t = 8 * w + i; const u32x2 qq = *(const LAS u32x2*)(lds + O_Q + t * QSTR + 8 * lane);
            float v = lo16(qq.x) * nv[0] + hi16(qq.x) * nv[1] + lo16(qq.y) * nv[2] + hi16(qq.y) * nv[3]; v = wsum(v); if (lane == 0) sQn[t] = v; }
    }
    __syncthreads();
    const int mt = w & 3, nq = w >> 2;
    f32x4 acc[4][2];
#pragma unroll
    for (int sl = 0; sl < 4; ++sl) { acc[sl][0] = (f32x4){0.f, 0.f, 0.f, 0.f}; acc[sl][1] = acc[sl][0]; }
    { const bf16_t* cbase = CST + (size_t)(bh * 64 + c) * 65536;
        const int fo = (lane & 15) * QSTR + 16 * (lane >> 4);
        u32x4 pre[4];
#define CT_LOAD(sl) do { _Pragma("unroll") for (int _i = 0; _i < 4; ++_i) { const int _ch = tid + 512 * _i; pre[_i] = *(const u32x4*)(cbase + (size_t)((sl) * 64 + (_ch >> 5)) * 256 + (_ch & 31) * 8); } } while (0)
#define CT_STORE() do { _Pragma("unroll") for (int _i = 0; _i < 4; ++_i) { const int _ch = tid + 512 * _i; *(LAS u32x4*)(lds + O_K + (_ch >> 5) * QSTR + (_ch & 31) * 16) = pre[_i]; } } while (0)
        CT_LOAD(0);
#pragma unroll
        for (int sl = 0; sl < 4; ++sl) {
            CT_STORE();
            if (sl < 3) CT_LOAD(sl + 1);
            __syncthreads();
#pragma unroll
            for (int ks = 0; ks < 8; ++ks) { const bf16x8 A = *(const LAS bf16x8*)(lds + O_Q + 16 * mt * QSTR + fo + 64 * ks);
#pragma unroll
                for (int j = 0; j < 2; ++j) { const bf16x8 B = *(const LAS bf16x8*)(lds + O_K + 16 * (2 * nq + j) * QSTR + fo + 64 * ks);
                    acc[sl][j] = __builtin_amdgcn_mfma_f32_16x16x32_bf16(A, B, acc[sl][j], 0, 0, 0); } }
            __syncthreads();
        }
#undef CT_LOAD
#undef CT_STORE
    }
    { float wi[4];
#pragma unroll
        for (int r = 0; r < 4; ++r) wi[r] = sWi[16 * mt + 4 * (lane >> 4) + r];
#pragma unroll
        for (int sl = 0; sl < 4; ++sl)
#pragma unroll
            for (int j = 0; j < 2; ++j)
#pragma unroll
                for (int r = 0; r < 4; ++r) acc[sl][j][r] *= wi[r];
        const int fo = (lane & 15) * KT_STR + 16 * (lane >> 4);
#pragma unroll
        for (int ks = 0; ks < 2; ++ks) { const bf16x8 A = *(const LAS bf16x8*)(lds + O_P + 16 * mt * KT_STR + fo + 64 * ks);
#pragma unroll
            for (int sl = 0; sl < 4; ++sl)
#pragma unroll
                for (int j = 0; j < 2; ++j) { const bf16x8 B = *(const LAS bf16x8*)(lds + O_VT + 16 * (4 * sl + 2 * nq + j) * KT_STR + fo + 64 * ks);
                    acc[sl][j] = __builtin_amdgcn_mfma_f32_16x16x32_bf16(A, B, acc[sl][j], 0, 0, 0); } }
    }
    { float s1[4] = {0.f, 0.f, 0.f, 0.f}, s2[4] = {0.f, 0.f, 0.f, 0.f};
#pragma unroll
        for (int r = 0; r < 4; ++r) { const int t = 16 * mt + 4 * (lane >> 4) + r; const float den = sWi[t] * sQn[t] + sRs[2 * t] + sRs[2 * t + 1];
            const float inv = __builtin_amdgcn_rcpf(fmaxf(fabsf(den), sEf[t]));
#pragma unroll
            for (int sl = 0; sl < 4; ++sl)
#pragma unroll
                for (int j = 0; j < 2; ++j) { const int dv = 16 * (4 * sl + 2 * nq + j) + (lane & 15);
                    const float og = bf2f(ZA[(row0 + t) * 4096 + 3072 + h * 256 + dv]);
                    const float hv = acc[sl][j][r] * inv * __builtin_amdgcn_rcpf(1.f + __expf(-og)); acc[sl][j][r] = hv; s1[r] += hv; s2[r] += hv * hv; } }
#pragma unroll
        for (int r = 0; r < 4; ++r) { float u = s1[r], v = s2[r];
            u += __shfl_xor(u, 1); u += __shfl_xor(u, 2); u += __shfl_xor(u, 4); u += __shfl_xor(u, 8);
            v += __shfl_xor(v, 1); v += __shfl_xor(v, 2); v += __shfl_xor(v, 4); v += __shfl_xor(v, 8);
            if ((lane & 15) == 0) { const int t = 16 * mt + 4 * (lane >> 4) + r; sSt[(t * 2 + nq) * 2] = u; sSt[(t * 2 + nq) * 2 + 1] = v; } }
    }
    __syncthreads();
    {
#pragma unroll
        for (int r = 0; r < 4; ++r) { const int t = 16 * mt + 4 * (lane >> 4) + r;
            const float su = sSt[t * 4] + sSt[t * 4 + 2], sq = sSt[t * 4 + 1] + sSt[t * 4 + 3];
            const float mu = su * (1.f / 256.f), var = fmaxf(sq * (1.f / 256.f) - mu * mu, 0.f), rstd = rsqrtf(var + LN_EPS);
#pragma unroll
            for (int sl = 0; sl < 4; ++sl)
#pragma unroll
                for (int j = 0; j < 2; ++j) { const int dv = 16 * (4 * sl + 2 * nq + j) + (lane & 15);
                    *(LAS bf16_t*)(lds + O_Q + t * QSTR + 2 * dv) = f2bf((acc[sl][j][r] - mu) * rstd * norm_g[h * 256 + dv]); } }
    }
    __syncthreads();
#pragma unroll
    for (int i = 0; i < 4; ++i) { const int ch = tid + 512 * i, t = ch >> 5, c16 = ch & 31;
        *(u32x4*)(HO + (row0 + t) * 2048 + 1024 + h * 256 + c16 * 8) = *(const LAS u32x4*)(lds + O_Q + t * QSTR + c16 * 16); }
    __syncthreads();
}
}
constexpr int N_PHASES = 11;
constexpr int CW_Q = 192;
constexpr int LDS_BASE_OFF = LDSCTL_OFF + 1024;

__global__ void __launch_bounds__(NWAVES * 64, 2) fwd(Args args) {
    __shared__ __attribute__((aligned(16))) unsigned char lds_raw[LDS_BYTES];
    Frame F;
    F.lds = (LAS unsigned char*)lds_raw;
    F.MISC = (volatile LAS unsigned*)(F.lds + MISC_OFF);
    F.tid = threadIdx.x; F.lane = F.tid & 63; F.wave = __builtin_amdgcn_readfirstlane(F.tid >> 6);
    F.G = gridDim.x; { const int bx = blockIdx.x; F.vcu = (F.G % 8 == 0) ? (bx % 8) * (F.G / 8) + bx / 8 : bx; }
    unsigned char* ws = args.ws;
    F.ctl = (unsigned*)(ws + WS_CTL);
    for (int u = F.tid; u < (LDS_BYTES - LDSCTL_OFF) / 4; u += NWAVES * 64) ((LAS unsigned*)(F.lds + LDSCTL_OFF))[u] = 0u;
    __syncthreads();
    const int lo = args.ph_lo, hi = args.ph_hi;
    XcdBarrier bar; bar.bar = F.ctl + CW_BAR + args.li * XCD_BAR_WORDS; bar.x = 0; bar.st = nullptr;
    if (hi - lo > 1) bar = xcd_barrier_post(F.ctl + CW_BAR + args.li * XCD_BAR_WORDS, F.MISC + 8, F.tid == 0);
#ifndef PHASE_MASK
#define PHASE_MASK 0x7ff
#endif
#define IN(k) ((((PHASE_MASK) >> (k)) & 1) && lo <= (k) && (k) < hi)
#ifndef BAR_REPS
#define BAR_REPS 1
#endif
#define SEAM(k) do { if (IN(k) && IN((k) + 1)) { for (int _b = 0; _b < BAR_REPS; ++_b) xcd_barrier(bar, F.wave); } } while (0)
    LAS int* lbase = (LAS int*)(F.lds + LDS_BASE_OFF);

#ifndef DUP_PHASE
#define DUP_PHASE (-1)
#endif
#define PHASE(k, BODY) do { if (IN(k)) { F.lane = (int)__builtin_amdgcn_mbcnt_hi(~0u, __builtin_amdgcn_mbcnt_lo(~0u, 0u)); F.tid = F.wave * 64 + F.lane;     \
        BODY(0); if (DUP_PHASE == (k)) { BODY(1); } SEAM(k); } } while (0)
#define PHASE_RT(k, BODY) do { if (IN(k)) { const int _nr = (args.pad == (k)) ? 2 : 1; for (int _rep = 0; _rep < _nr; ++_rep) { BODY(_rep); } SEAM(k); } } while (0)

#define BODY0(rep) do { p0_prologue(F, args); } while (0)
    PHASE(0, BODY0);

#define BODY1(rep) do { pg8::GridOrder S; S.init(ws + WS_XB, DM * 2, ws + WS_WIN_T, DM * 2, T_TOK, N_MAIN, F.G, (int)blockIdx.x); \
        EpIn E{args.in[2], (bf16_t*)(ws + WS_ZA), (bf16_t*)(ws + WS_ZB), (bf16_t*)(ws + WS_ZG)}; \
        pg8::gemm_phase<EpIn, pg8::GridOrder>(F.lds, F.tid, DM, DM * 2, DM * 2, S, E); } while (0)
    PHASE(1, BODY1);

#define BODY2(rep) do { for (int u = F.vcu; u < 1024; u += F.G) mls::dc_unit(F, args, u >> 6, u & 63); } while (0)
    PHASE(2, BODY2);

#define QNEXT(word, dst) do { if (F.tid == 0) *qslot = (int)__hip_atomic_fetch_add(F.ctl + (word), 1u, __ATOMIC_RELAXED, __HIP_MEMORY_SCOPE_AGENT); __syncthreads(); dst = *qslot; __syncthreads(); } while (0)
#define BODY3(rep) do { \
        volatile LAS int* qslot = (volatile LAS int*)(F.lds + LDS_BASE_OFF + 256); \
        const int qw = CW_Q + 64 * (rep) + 128 * args.li; \
        if (args.pad < 101) for (;;) { int item; QNEXT(qw, item); if (item >= 256) break; mls::scan_item(F, args, item >> 4, item & 15); } \
        if (args.pad != 100) { \
            const float lam = __expf(wsum(args.in[6][F.lane] * args.in[7][F.lane])) - __expf(wsum(args.in[8][F.lane] * args.in[9][F.lane])) + LAMBDA_INIT; \
            LAS float* dngl = (LAS float*)(F.lds + LDS_BASE_OFF + 512); if (F.tid < 128) dngl[F.tid] = args.in[10][F.tid]; __syncthreads(); \
            for (;;) { int P; QNEXT(qw + 32, P); if (P >= 512) break;         \
                const int bh = (((P >> 4) & 3) << 3) + (7 - (P >> 6)), pp = P & 15; \
                att::unit(F, args, bh >> 3, bh & 7, pp, lam, dngl); att::unit(F, args, bh >> 3, bh & 7, 31 - pp, lam, dngl); } } \
        } while (0)
    PHASE(3, BODY3);

#define BODY4(rep) do { for (int u = F.vcu; u < 1024; u += F.G) mls::out_unit(F, args, u >> 6, u & 63); } while (0)
    PHASE(4, BODY4);

#define BODY5(rep) do { pg8::GridOrder2K S; S.g.init(ws + WS_XB, DM * 2, ws + WS_WA_T, DM * 2, T_TOK, DM, F.G, (int)blockIdx.x); S.khalf_bytes = 1024 * 2; \
        EpMerge E{(const bf16_t*)(ws + WS_ZG), (bf16_t*)(ws + WS_MG)}; \
        pg8::gemm_phase<EpMerge, pg8::GridOrder2K, false, true>(F.lds, F.tid, 1024, DM * 2, DM * 2, S, E); } while (0)
    PHASE(5, BODY5);

#define BODY6(rep) do { pg8::GridOrder S; S.init(ws + WS_MG, DM * 2, ws + WS_WOUT_T, DM * 2, T_TOK, DM, F.G, (int)blockIdx.x); \
        EpOutR E{args.in[0], (bf16_t*)(ws + WS_R), (float*)(ws + WS_CTL) + CW_STATS}; \
        pg8::gemm_phase<EpOutR, pg8::GridOrder>(F.lds, F.tid, DM, DM * 2, DM * 2, S, E); } while (0)
    PHASE(6, BODY6);

#define BODY7(rep) do { if (args.pad != 107) for (int u = F.vcu; u < T_TOK / 64; u += F.G) ln1_route_unit(F, args, u); \
        moe_gu_copies(F, args); moe_down_copies_all(F, args); } while (0)
    if (IN(7)) { F.lane = (int)__builtin_amdgcn_mbcnt_hi(~0u, __builtin_amdgcn_mbcnt_lo(~0u, 0u)); F.tid = F.wave * 64 + F.lane; BODY7(0); SEAM(7); }

#define BODY8(rep) do { moe_base_to_lds(F, args, lbase); \
        MoeOrder S{lbase, (const int*)(ws + WS_CTL) + CW_CNT, (const int*)(ws + WS_LIST), 4, F.G, (int)blockIdx.x, 1, (const char*)(ws + WS_X1B), (const char*)(ws + WS_WGU_T), \
                   (size_t)1024 * DM * 2, 0, (size_t)256 * DM * 2}; \
        EpUp E{(bf16_t*)(ws + WS_H)}; \
        pg8::gemm_phase<EpUp, MoeOrder, true>(F.lds, F.tid, DM, DM * 2, DM * 2, S, E); } while (0)
    PHASE(8, BODY8);

#define BODY9(rep) do { moe_base_to_lds(F, args, lbase); \
        MoeOrder S{lbase, (const int*)(ws + WS_CTL) + CW_CNT, (const int*)(ws + WS_LIST), 8, F.G, (int)blockIdx.x, 0, (const char*)(ws + WS_H), (const char*)(ws + WS_WD_T), \
                   (size_t)DM * DE * 2, (size_t)256 * DE * 2, (size_t)256 * DE * 2}; \
        EpDown E{(bf16_t*)(ws + WS_Y)}; \
        pg8::gemm_phase<EpDown, MoeOrder>(F.lds, F.tid, DE, DE * 2, DE * 2, S, E); } while (0)
    PHASE(9, BODY9);

#define BODY10(rep) do { moe_base_to_lds(F, args, lbase); \
        const int gw = F.vcu * NWAVES + F.wave, NGW = F.G * NWAVES; \
        for (int m = gw; m < T_TOK; m += NGW) ln2_row(F, args, m, lbase); } while (0)
    PHASE(10, BODY10);
#undef IN
#undef SEAM
}

#ifndef RT_DUP
#define RT_DUP (-1)
#endif
static int g_grid = 0;
static bool mega_setup() {
    if (g_grid) return g_grid > 0;
    int dev = 0, cus = 0, per_cu = 0;
    if (hipGetDevice(&dev) != hipSuccess || hipDeviceGetAttribute(&cus, hipDeviceAttributeMultiprocessorCount, dev) != hipSuccess || cus <= 0) { cus = 256; (void)hipGetLastError(); }
    if (hipOccupancyMaxActiveBlocksPerMultiprocessor(&per_cu, (const void*)fwd, NWAVES * 64, 0) != hipSuccess || per_cu < 1) fprintf(stderr, "note: occupancy query reports %d blocks per CU\n", per_cu);
    (void)hipGetLastError();
    g_grid = cus;
    return true;
}
static void launch_mega(void* const* d_in, float* out, unsigned char* ws, hipStream_t st, int lo, int hi, int li, int flag = -1) {
    Args a{};
    for (int i = 0; i < 25; ++i) a.in[i] = (const float*)d_in[i];
    a.out = out; a.ws = ws; a.ph_lo = lo; a.ph_hi = hi; a.li = li; a.pad = flag;
    hipLaunchKernelGGL(fwd, dim3(g_grid), dim3(NWAVES * 64), 0, st, a);
}
extern "C" void kernel_launch(void* const* d_in, const int* in_sizes, int n_in, void* d_out, int out_size, void* d_ws, size_t ws_size, hipStream_t stream) {
    if (n_in != 25 || out_size != T_TOK * DM || ws_size < WS_END) { fprintf(stderr, "kernel_launch: unexpected arguments (n_in %d out %d ws %zu)\n", n_in, out_size, ws_size); return; }
    (void)in_sizes;
    if (!mega_setup()) return;
    (void)hipMemsetAsync((char*)d_ws + WS_CTL, 0, 1 * MiB, stream);
    launch_mega(d_in, (float*)d_out, (unsigned char*)d_ws, stream, 0, 11, 0);
}
```

```cpp
#include <hip/hip_runtime.h>
#include <cstdio>
#include <cstdint>
#include <cmath>

typedef unsigned short bf16_t;
typedef short bf16x8 __attribute__((ext_vector_type(8)));
typedef float f32x4 __attribute__((ext_vector_type(4)));
typedef float f32x16 __attribute__((ext_vector_type(16)));
typedef unsigned u32x4 __attribute__((ext_vector_type(4)));
typedef unsigned u32x2 __attribute__((ext_vector_type(2)));

constexpr int DM = 2048, BATCH = 4, SEQ = 4096, T_TOK = BATCH * SEQ;
constexpr int N_IN = 11272, N_MAIN = 11264;
constexpr int NEXP = 32, DE = 512;
constexpr float ALPHA = 1.189207115002721f;
constexpr float LN_EPS = 1e-5f;
constexpr float LAMBDA_INIT = 0.2f;
constexpr int PMAX = 40960;

__device__ __forceinline__ float bf2f(bf16_t b) { return __uint_as_float(((unsigned)b) << 16); }
__device__ __forceinline__ unsigned f2bf_u(float f) { unsigned u = __float_as_uint(f); return (u + 0x7fffu + ((u >> 16) & 1u)) >> 16; }
__device__ __forceinline__ bf16_t f2bf(float f) { return (bf16_t)f2bf_u(f); }
__device__ __forceinline__ unsigned pk2(float lo, float hi) { return f2bf_u(lo) | (f2bf_u(hi) << 16); }

constexpr size_t MiB = 1u << 20;
constexpr size_t WS_CTL = 0;
constexpr size_t WS_GATES = 1 * MiB;
constexpr size_t WS_TOKE = 2 * MiB;
constexpr size_t WS_TOKP = 2 * MiB + 256 * 1024;
constexpr size_t WS_TOKW = 2 * MiB + 512 * 1024;
constexpr size_t WS_LIST = 3 * MiB;
constexpr size_t WS_SCAL = 5 * MiB;
constexpr size_t WS_WRT = 7 * MiB;
constexpr size_t WS_WIN_T = 8 * MiB;
constexpr size_t WS_WA_T = 52 * MiB, WS_WB_T = 56 * MiB, WS_WOUT_T = 60 * MiB;
constexpr size_t WS_XB = 68 * MiB;
constexpr size_t WS_HA = 68 * MiB, WS_OB = 100 * MiB;
constexpr size_t WS_WD_T = 68 * MiB;
constexpr size_t WS_CST = 132 * MiB;
constexpr size_t WS_WGU_T = 132 * MiB;
constexpr size_t WS_ZG = 260 * MiB;
constexpr size_t WS_R = 260 * MiB;
constexpr size_t WS_ZB = 388 * MiB;
constexpr size_t WS_X1B = 388 * MiB;
constexpr size_t WS_Y = 388 * MiB;
constexpr size_t WS_ZA = 484 * MiB;
constexpr size_t WS_MG = 484 * MiB;
constexpr size_t WS_H = 572 * MiB;
constexpr size_t WS_END = 612 * MiB;
constexpr int CW_CNT = 64;
constexpr int CW_BASE = 128;
constexpr int CW_STATS = 131072;
namespace pg8 {
#define PG8_LAS __attribute__((address_space(3)))
constexpr int BM = 256, BK = 64, HALF = 128, HTB = HALF * BK * 2, STAGE_BYTES = 8 * HTB, NXCD = 8, WGM = 8;

__host__ __device__ __forceinline__ int lds_byte(int r, int c) { const int st = (r >> 4) * 2 + (c >> 5), rr = r & 15, cc = c & 31, ob = rr * 64 + cc * 2; return st * 1024 + (ob ^ (((ob >> 9) & 1) << 5)); }
__host__ __device__ __forceinline__ void stage_rc(int b, int& R, int& C) { const int st = b / 1024, sb = b % 1024, swz = sb ^ (((sb >> 9) & 1) << 5); R = (st >> 1) * 16 + swz / 64; C = (st & 1) * 32 + (swz % 64) / 2; }
__host__ __device__ __forceinline__ int perm32(int rho) { const int n = rho >> 4, i = rho & 15; return 8 * (i >> 2) + 4 * n + (i & 3); }

struct Unit { int pm, pn, e, pad; const char* abase; const char* bbase; const int* arow; };

struct GridOrder {
    int nM, nN, nwg, G, c; const char* A; const char* Bt; size_t a_tstep, b_tstep;
    __device__ void init(const void* A_, int lda_bytes, const void* Bt_, int ldb_bytes, int M, int N, int G_, int c_) { nM = M / BM; nN = N / BM; nwg = nM * nN; G = G_; c = c_; A = (const char*)A_; Bt = (const char*)Bt_;
        a_tstep = (size_t)BM * lda_bytes; b_tstep = (size_t)BM * ldb_bytes; }
    __device__ bool next(int i, Unit& u) const {
        const long L = (long)i * G + c; if (L >= nwg) return false;
        int wgid = (int)L; { const int q = nwg / NXCD, r = nwg % NXCD, xcd = wgid % NXCD, off = wgid / NXCD; wgid = (xcd < r ? xcd * (q + 1) : r * (q + 1) + (xcd - r) * q) + off; }
        const int nig = WGM * nN, gid = wgid / nig, fm = gid * WGM, gsz = (nM - fm) < WGM ? (nM - fm) : WGM;
        u.pm = fm + ((wgid % nig) % gsz); u.pn = (wgid % nig) / gsz; u.e = 0; u.pad = 0;
        u.abase = A + (size_t)u.pm * a_tstep; u.bbase = Bt + (size_t)u.pn * b_tstep; u.arow = nullptr; return true;
    }
};

struct GridOrder2K {
    GridOrder g; size_t khalf_bytes;
    __device__ bool next(int i, Unit& u) const { if (!g.next(i >> 1, u)) return false; const int h = i & 1; u.e = h ? 0 : 1; u.abase += (size_t)h * khalf_bytes; u.bbase += (size_t)h * khalf_bytes; return true; }
};

__device__ __forceinline__ unsigned cvt_pk_bf16(float lo, float hi) { unsigned r; asm volatile("v_cvt_pk_bf16_f32 %0, %1, %2" : "=v"(r) : "v"(lo), "v"(hi)); return r; }

typedef f32x4 acc_t[2][2][4][2];

template <class Epi, class Sched, bool GATHER = false, bool MIDHOOK = false>
__device__ __forceinline__ void gemm_phase(PG8_LAS unsigned char* lds, const int tid, const int K, const int lda_b  , const int ldb_b  , const Sched& S, const Epi& E) {
    const int wid = __builtin_amdgcn_readfirstlane(tid >> 6), lane = tid & 63, wr = wid >> 2, wc = wid & 3, fr = lane & 15, fq = lane >> 4;
    const int nt = K / BK;
    unsigned vA[2][2], vAn[2][2], voffB[2];
#pragma unroll
    for (int i = 0; i < 2; ++i) { int R, C; stage_rc(tid * 16 + i * 8192, R, C); const int Rb = Epi::PERM ? ((R & ~31) + perm32(R & 31)) : R;
        voffB[i] = (unsigned)(Rb * ldb_b + C * 2);
        vA[0][i] = (unsigned)(R * lda_b + C * 2); vA[1][i] = (unsigned)((R + HALF) * lda_b + C * 2); vAn[0][i] = vA[0][i]; vAn[1][i] = vA[1][i]; }
    const size_t kstep = (size_t)(BK * 2);
    const size_t hstepB = (size_t)HALF * ldb_b;
    const unsigned ldsw = (unsigned)wid * 1024u;
    const int aoff = lds_byte(wr * 64 + fr, fq * 8), boff = lds_byte(wc * 32 + fr, fq * 8);
#define PG8_SA(b, h) (((b) * 2 + (h)) * HTB)
#define PG8_SB(b, h) ((4 + (b) * 2 + (h)) * HTB)
#define PG8_STAGE(bufoff, gbase, voff) do { _Pragma("unroll") for (int _i = 0; _i < 2; ++_i) \
        __builtin_amdgcn_global_load_lds((const unsigned*)((const char*)(gbase) + (voff)[_i]), (PG8_LAS unsigned*)(lds + (bufoff) + ldsw + _i * 8192), 16, 0, 0); } while (0)
#define PG8_STAGE_A(bufoff, gbase, h, nx) do { \
        __builtin_amdgcn_global_load_lds((const unsigned*)((const char*)(gbase) + ((nx) ? vAn[h][0] : vA[h][0])), (PG8_LAS unsigned*)(lds + (bufoff) + ldsw), 16, 0, 0); \
        __builtin_amdgcn_global_load_lds((const unsigned*)((const char*)(gbase) + ((nx) ? vAn[h][1] : vA[h][1])), (PG8_LAS unsigned*)(lds + (bufoff) + ldsw + 8192), 16, 0, 0); } while (0)
#define PG8_LDA(dst, b, h) do { _Pragma("unroll") for (int m = 0; m < 4; ++m) _Pragma("unroll") for (int k = 0; k < 2; ++k) dst[m][k] = *(const PG8_LAS bf16x8*)(lds + PG8_SA(b, h) + aoff + m * 2048 + k * 1024); } while (0)
#define PG8_LDB(dst, b, h) do { _Pragma("unroll") for (int n = 0; n < 2; ++n) _Pragma("unroll") for (int k = 0; k < 2; ++k) dst[n][k] = *(const PG8_LAS bf16x8*)(lds + PG8_SB(b, h) + boff + n * 2048 + k * 1024); } while (0)
#define PG8_MMA(ai, bj, At, Bt) do { __builtin_amdgcn_s_setprio(1); _Pragma("unroll") for (int m = 0; m < 4; ++m) _Pragma("unroll") for (int n = 0; n < 2; ++n) _Pragma("unroll") for (int k = 0; k < 2; ++k) \
        acc[ai][bj][m][n] = __builtin_amdgcn_mfma_f32_16x16x32_bf16(Bt[n][k], At[m][k], acc[ai][bj][m][n], 0, 0, 0); __builtin_amdgcn_s_setprio(0); } while (0)
#define PG8_WAIT_V(n) asm volatile("s_waitcnt vmcnt(" #n ")" ::: "memory")
#define PG8_WAIT_L(n) asm volatile("s_waitcnt lgkmcnt(" #n ")" ::: "memory")
#define PG8_BAR __builtin_amdgcn_s_barrier()
#define PG8_SCHED __builtin_amdgcn_sched_barrier(0)
#define PG8_GATHER_OFFS(dst, u) do { if constexpr (GATHER) { _Pragma("unroll") for (int _h = 0; _h < 2; ++_h) _Pragma("unroll") for (int _i = 0; _i < 2; ++_i) \
        { int _R, _C; stage_rc(tid * 16 + _i * 8192, _R, _C); const int _r = _h * HALF + _R; const int _tok = (_r < (u).pad) ? (u).arow[_r] : 0; dst[_h][_i] = (unsigned)_tok * (unsigned)lda_b + (unsigned)(_C * 2); } } } while (0)
    Unit cur, nxt; int ui = 0;
    if (!S.next(0, cur)) return;
    acc_t acc;
#pragma unroll
    for (int a = 0; a < 2; ++a)
#pragma unroll
        for (int b = 0; b < 2; ++b)
#pragma unroll
            for (int m = 0; m < 4; ++m)
#pragma unroll
                for (int n = 0; n < 2; ++n) acc[a][b][m][n] = (f32x4){0.f, 0.f, 0.f, 0.f};
    bf16x8 At[4][2], B0[2][2], B1[2][2];
    const char* cA = cur.abase; const char* cB = cur.bbase;
    PG8_GATHER_OFFS(vA, cur);
    PG8_STAGE(PG8_SB(0, 0), cB, voffB); PG8_STAGE(PG8_SB(0, 1), cB + hstepB, voffB); PG8_STAGE_A(PG8_SA(0, 0), cA, 0, false); PG8_STAGE_A(PG8_SA(0, 1), cA, 1, false);
    if (wr == 1) PG8_BAR;
    PG8_WAIT_V(2); PG8_BAR;
    PG8_STAGE(PG8_SB(1, 0), cB + kstep, voffB); PG8_STAGE_A(PG8_SA(1, 0), cA + kstep, 0, false); PG8_STAGE(PG8_SB(1, 1), cB + hstepB + kstep, voffB);
    PG8_WAIT_V(6); PG8_BAR;
    for (;;) {
        const bool has_next = S.next(ui + 1, nxt);
        const char* nA = has_next ? nxt.abase : cA; const char* nB = has_next ? nxt.bbase : cB;
        for (int t = 0; t < nt; t += 2) {
            const bool last = (t == nt - 2);
            const char* a1 = cA + (size_t)(t + 1) * kstep;
            const char* a2 = last ? nA : cA + (size_t)(t + 2) * kstep; const char* b2 = last ? nB : cB + (size_t)(t + 2) * kstep;
            const char* a3 = a2 + kstep; const char* b3 = b2 + kstep;
            const bool nx = GATHER ? last : false;
            if constexpr (GATHER) { if (last) { if (has_next) { PG8_GATHER_OFFS(vAn, nxt); } else {
#pragma unroll
                for (int h = 0; h < 2; ++h)
#pragma unroll
                    for (int i = 0; i < 2; ++i) vAn[h][i] = vA[h][i]; } } }
            PG8_LDB(B0, 0, 0); PG8_LDB(B1, 0, 1); PG8_SCHED; PG8_LDA(At, 0, 0); PG8_STAGE_A(PG8_SA(1, 1), a1, 1, false);
            PG8_WAIT_V(8); PG8_WAIT_L(0); PG8_BAR; PG8_MMA(0, 0, At, B0); PG8_MMA(0, 1, At, B1); PG8_BAR; PG8_SCHED;
            PG8_LDA(At, 0, 1); PG8_STAGE(PG8_SB(0, 0), b2, voffB); PG8_STAGE(PG8_SB(0, 1), b2 + hstepB, voffB); PG8_STAGE_A(PG8_SA(0, 0), a2, 0, nx);
            PG8_WAIT_V(8); PG8_WAIT_L(0); PG8_BAR; PG8_MMA(1, 0, At, B0); PG8_MMA(1, 1, At, B1); PG8_BAR; PG8_SCHED;
            PG8_LDB(B0, 1, 0); PG8_LDB(B1, 1, 1); PG8_SCHED; PG8_LDA(At, 1, 0); PG8_STAGE_A(PG8_SA(0, 1), a2, 1, nx);
            PG8_WAIT_V(8); PG8_WAIT_L(0); PG8_BAR; PG8_MMA(0, 0, At, B0); PG8_MMA(0, 1, At, B1); PG8_BAR; PG8_SCHED;
            PG8_LDA(At, 1, 1); PG8_STAGE(PG8_SB(1, 0), b3, voffB); PG8_STAGE(PG8_SB(1, 1), b3 + hstepB, voffB); PG8_STAGE_A(PG8_SA(1, 0), a3, 0, nx);
            PG8_WAIT_V(8); PG8_WAIT_L(0); PG8_BAR; PG8_MMA(1, 0, At, B0); PG8_MMA(1, 1, At, B1); PG8_BAR; PG8_SCHED;
        }
        if (wr == 0) PG8_BAR;
        E(acc, cur, wr, wc, fr, fq);
        if (!has_next) break;
        if constexpr (MIDHOOK) { const float kz = (cur.e != 0) ? 1.f : 0.f;
#pragma unroll
            for (int a = 0; a < 2; ++a)
#pragma unroll
                for (int b = 0; b < 2; ++b)
#pragma unroll
                    for (int m = 0; m < 4; ++m)
#pragma unroll
                        for (int n = 0; n < 2; ++n)
#pragma unroll
                            for (int j = 0; j < 4; ++j) asm volatile("v_mul_f32_e32 %0, %1, %0" : "+v"(acc[a][b][m][n][j]) : "v"(kz));
        } else {
#pragma unroll
            for (int a = 0; a < 2; ++a)
#pragma unroll
                for (int b = 0; b < 2; ++b)
#pragma unroll
                    for (int m = 0; m < 4; ++m)
#pragma unroll
                        for (int n = 0; n < 2; ++n) acc[a][b][m][n] = (f32x4){0.f, 0.f, 0.f, 0.f};
        }
        cur = nxt; cA = nA; cB = nB; ++ui;
        if constexpr (GATHER) {
#pragma unroll
            for (int h = 0; h < 2; ++h)
#pragma unroll
                for (int i = 0; i < 2; ++i) vA[h][i] = vAn[h][i]; }
        if (wr == 1) PG8_BAR;
    }
    PG8_WAIT_V(0);
    PG8_BAR;
#undef PG8_SA
#undef PG8_SB
#undef PG8_STAGE
#undef PG8_STAGE_A
#undef PG8_LDA
#undef PG8_LDB
#undef PG8_MMA
#undef PG8_WAIT_V
#undef PG8_WAIT_L
#undef PG8_BAR
#undef PG8_SCHED
#undef PG8_GATHER_OFFS
}
}
#define GAS __attribute__((address_space(1)))
#define LAS __attribute__((address_space(3)))
typedef GAS unsigned gu32;
#define RLX_AGENT __ATOMIC_RELAXED, __HIP_MEMORY_SCOPE_AGENT
#define LDS_WAIT() asm volatile("s_waitcnt lgkmcnt(0)" ::: "memory")
#define VM_WAIT() asm volatile("s_waitcnt vmcnt(0)" ::: "memory")

#define XB_TMO      128
#define XB_XCNT(j)  (256  + 64 * (j))
#define XB_XSUB(j)  (1280 + 64 * (j))
#define XB_XGEN(j)  (2304 + 64 * (j))
#define XB_TOP      3328
#define XB_TOPGEN   3392
#define XCD_BAR_WORDS 3456
#define XB_SPIN_CAP (1u << 20)

__device__ __forceinline__ unsigned xb_ld(unsigned* p)              { return __hip_atomic_load(p, __ATOMIC_RELAXED, __HIP_MEMORY_SCOPE_AGENT); }
__device__ __forceinline__ unsigned xb_add(unsigned* p, unsigned v) { return __hip_atomic_fetch_add(p, v, __ATOMIC_RELAXED, __HIP_MEMORY_SCOPE_AGENT); }
__device__ __forceinline__ unsigned xb_xcc_id() { return (unsigned)__builtin_amdgcn_s_getreg((3 << 11) | 20) & 0xFu; }
#define XB_SPIN(cond, bar) do { unsigned _sp = 0; while (cond) { __builtin_amdgcn_s_sleep(1); \
    if ((++_sp & 255u) == 0u) { if (xb_ld(&(bar)[XB_TMO])) break; if (_sp > XB_SPIN_CAP) { atomicAdd(&(bar)[XB_TMO], 1u); break; } } } } while (0)

struct XcdBarrier { unsigned* bar; unsigned x; volatile LAS unsigned* st; };

__device__ __forceinline__ XcdBarrier xcd_barrier_post(unsigned* bar, volatile LAS unsigned* st, bool thread0) {
    XcdBarrier b; b.bar = bar; b.x = xb_xcc_id(); b.st = st;
    if (thread0) (void)xb_add(&bar[XB_XCNT(b.x)], 1u);
    return b;
}
__device__ __forceinline__ void xcd_barrier_complete(unsigned* bar, unsigned x, unsigned& nloc, unsigned& nx) {
    const unsigned G = gridDim.x * gridDim.y * gridDim.z;
    unsigned sum, cnt, mine, sp = 0u;
    for (;;) {
        sum = 0u; cnt = 0u; mine = 0u;
#pragma unroll
        for (unsigned j = 0; j < 16; ++j) { const unsigned c = xb_ld(&bar[XB_XCNT(j)]); sum += c; cnt += (c > 0u) ? 1u : 0u; mine = (j == x) ? c : mine; }
        if (sum == G) break;
        __builtin_amdgcn_s_sleep(1);
        if ((++sp & 255u) == 0u) { if (xb_ld(&bar[XB_TMO])) break; if (sp > XB_SPIN_CAP) { atomicAdd(&bar[XB_TMO], 1u); break; } }
    }
    nloc = mine > 0u ? mine : 1u; nx = cnt > 0u ? cnt : 1u;
}
__device__ __forceinline__ void xcd_barrier(const XcdBarrier& b, int wave  ) {
    asm volatile("s_waitcnt vmcnt(0)" ::: "memory");
    __syncthreads();
    if (wave == 0 && __builtin_amdgcn_mbcnt_hi(~0u, __builtin_amdgcn_mbcnt_lo(~0u, 0u)) == 0u) {
        unsigned* bar = b.bar;
        __builtin_amdgcn_s_waitcnt(0);
        unsigned nloc = b.st[0], nx = b.st[1];
        if (nloc == 0u) { xcd_barrier_complete(bar, b.x, nloc, nx); b.st[0] = nloc; b.st[1] = nx; }
        const unsigned old = xb_add(&bar[XB_XSUB(b.x)], 1u);
        const unsigned gen = old / nloc;
        if (old + 1u == (gen + 1u) * nloc) {
            __builtin_amdgcn_fence(__ATOMIC_RELEASE, "agent");
            asm volatile("s_waitcnt vmcnt(0)" ::: "memory");
            const unsigned og = xb_add(&bar[XB_TOP], 1u);
            const unsigned tg = og / nx;
            if (og + 1u == (tg + 1u) * nx) xb_add(&bar[XB_TOPGEN], 1u);
            else XB_SPIN(xb_ld(&bar[XB_TOPGEN]) == tg, bar);
            __builtin_amdgcn_fence(__ATOMIC_ACQUIRE, "agent");
            xb_add(&bar[XB_XGEN(b.x)], 1u);
            asm volatile("s_waitcnt vmcnt(0)" ::: "memory");
        } else {
            XB_SPIN(xb_ld(&bar[XB_XGEN(b.x)]) == gen, bar);
            __builtin_amdgcn_fence(__ATOMIC_ACQUIRE, "agent");
            asm volatile("s_waitcnt vmcnt(0)" ::: "memory");
        }
    }
    __syncthreads();
}

constexpr int RING_BYTES = 131072;
constexpr int LDSCTL_OFF = RING_BYTES, MISC_OFF = LDSCTL_OFF + 320;
constexpr int LDS_BYTES = 147456;
constexpr int NWAVES = 8;
constexpr int CW_BAR = 4096;
static_assert((CW_BAR + XCD_BAR_WORDS) * 4 <= (int)(1 * MiB), "CTL");

__device__ __forceinline__ float wsum(float v) {
#pragma unroll
    for (int o = 1; o < 64; o <<= 1) v += __shfl_xor(v, o);
    return v;
}
__device__ __forceinline__ float wmaxf(float v) {
#pragma unroll
    for (int o = 1; o < 64; o <<= 1) v = fmaxf(v, __shfl_xor(v, o));
    return v;
}
__device__ __forceinline__ float sigm(float x) { return 1.f / (1.f + __expf(-x)); }

using pg8::acc_t; using pg8::Unit; using pg8::HALF; using pg8::BM; using pg8::cvt_pk_bf16;

struct EpIn {
    static constexpr bool PERM = true;
    const float* b_in; bf16_t* ZA; bf16_t* ZB; bf16_t* ZG;
    __device__ __forceinline__ void operator()(acc_t& acc, const Unit& u, int wr, int wc, int fr, int fq) const {
        const int colt = u.pn * BM; bf16_t* base; int ldc, c0, boff;
        if (colt < 4096) { base = ZA; ldc = 4096; c0 = colt; boff = 0; } else if (colt < 7168) { base = ZB; ldc = 3072; c0 = colt - 4096; boff = 8; } else { base = ZG; ldc = 4096; c0 = colt - 7168; boff = 8; }
        const int row0 = u.pm * BM + wr * 64 + fr, cl = wc * 32 + 8 * fq;
        f32x4 bv[2][2];
#pragma unroll
        for (int bj = 0; bj < 2; ++bj)
#pragma unroll
            for (int n = 0; n < 2; ++n) bv[bj][n] = *(const f32x4*)(b_in + colt + boff + cl + bj * HALF + 4 * n);
#pragma unroll
        for (int ai = 0; ai < 2; ++ai)
#pragma unroll
            for (int m = 0; m < 4; ++m) { bf16_t* rowp = base + (size_t)(row0 + ai * HALF + m * 16) * ldc + c0 + cl;
#pragma unroll
                for (int bj = 0; bj < 2; ++bj) { const f32x4 v0 = acc[ai][bj][m][0] + bv[bj][0], v1 = acc[ai][bj][m][1] + bv[bj][1];
                    u32x4 w; w.x = cvt_pk_bf16(v0[0], v0[1]); w.y = cvt_pk_bf16(v0[2], v0[3]); w.z = cvt_pk_bf16(v1[0], v1[1]); w.w = cvt_pk_bf16(v1[2], v1[3]);
                    *(u32x4*)(rowp + bj * HALF) = w; } }
    }
};
__device__ __forceinline__ void unpack8(const u32x4 w, float (&f)[8]) {
    f[0] = __uint_as_float(w.x << 16); f[1] = __uint_as_float(w.x & 0xffff0000u); f[2] = __uint_as_float(w.y << 16); f[3] = __uint_as_float(w.y & 0xffff0000u);
    f[4] = __uint_as_float(w.z << 16); f[5] = __uint_as_float(w.z & 0xffff0000u); f[6] = __uint_as_float(w.w << 16); f[7] = __uint_as_float(w.w & 0xffff0000u);
}
struct EpMerge {
    static constexpr bool PERM = true;
    const bf16_t* ZG; bf16_t* MG;
    __device__ __forceinline__ void operator()(acc_t& acc, const Unit& u, int wr, int wc, int fr, int fq) const {
        const int row0 = u.pm * BM + wr * 64 + fr, col0 = u.pn * BM + wc * 32 + 8 * fq; const bool first = u.e != 0;
#pragma unroll
        for (int ai = 0; ai < 2; ++ai)
#pragma unroll
            for (int m = 0; m < 4; ++m) { const size_t r = (size_t)(row0 + ai * HALF + m * 16); const bf16_t* gp = ZG + r * 4096 + col0;
#pragma unroll
                for (int bj = 0; bj < 2; ++bj) { float ga[8], gb[8], o[8]; unpack8(*(const u32x4*)(gp + bj * HALF), ga); unpack8(*(const u32x4*)(gp + 2048 + bj * HALF), gb);
#pragma unroll
                    for (int j = 0; j < 8; ++j) { const float ea = 1.f + __expf(-ga[j]), eb = 1.f + __expf(-gb[j]); const float mul = first ? ea * __builtin_amdgcn_rcpf(eb) : 1.f;
                        asm volatile("v_mul_f32_e32 %0, %1, %0" : "+v"(acc[ai][bj][m][j >> 2][j & 3]) : "v"(mul)); o[j] = acc[ai][bj][m][j >> 2][j & 3] * __builtin_amdgcn_rcpf(ea); }
                    if (!first) { u32x4 w; w.x = cvt_pk_bf16(o[0], o[1]); w.y = cvt_pk_bf16(o[2], o[3]); w.z = cvt_pk_bf16(o[4], o[5]); w.w = cvt_pk_bf16(o[6], o[7]);
                        *(u32x4*)(MG + r * DM + col0 + bj * HALF) = w; } }
                __builtin_amdgcn_sched_barrier(0); }
    }
};
struct EpOutR {
    static constexpr bool PERM = true;
    const float* x; bf16_t* R; float* stats;
    __device__ __forceinline__ void operator()(acc_t& acc, const Unit& u, int wr, int wc, int fr, int fq) const {
        const int row0 = u.pm * BM + wr * 64 + fr, col0 = u.pn * BM + wc * 32 + 8 * fq;
#pragma unroll
        for (int ai = 0; ai < 2; ++ai)
#pragma unroll
            for (int m = 0; m < 4; ++m) { const int row = row0 + ai * HALF + m * 16; const size_t off = (size_t)row * DM + col0; float s = 0.f, q = 0.f;
#pragma unroll
                for (int bj = 0; bj < 2; ++bj) { const f32x4 x0 = *(const f32x4*)(x + off + bj * HALF), x1 = *(const f32x4*)(x + off + bj * HALF + 4);
                    const f32x4 v0 = x0 * ALPHA + acc[ai][bj][m][0], v1 = x1 * ALPHA + acc[ai][bj][m][1];
                    u32x4 w; w.x = cvt_pk_bf16(v0[0], v0[1]); w.y = cvt_pk_bf16(v0[2], v0[3]); w.z = cvt_pk_bf16(v1[0], v1[1]); w.w = cvt_pk_bf16(v1[2], v1[3]);
                    *(u32x4*)(R + off + bj * HALF) = w;
                    s += ((v0[0] + v0[1]) + (v0[2] + v0[3])) + ((v1[0] + v1[1]) + (v1[2] + v1[3]));
                    q += ((v0[0] * v0[0] + v0[1] * v0[1]) + (v0[2] * v0[2] + v0[3] * v0[3])) + ((v1[0] * v1[0] + v1[1] * v1[1]) + (v1[2] * v1[2] + v1[3] * v1[3])); }
                s += __shfl_xor(s, 16); s += __shfl_xor(s, 32); q += __shfl_xor(q, 16); q += __shfl_xor(q, 32);
                if (fq == 0) { atomicAdd(stats + 2 * row, s); atomicAdd(stats + 2 * row + 1, q); } }
    }
};
struct EpUp {
    static constexpr bool PERM = true;
    bf16_t* H;
    __device__ __forceinline__ void operator()(acc_t& acc, const Unit& u, int wr, int wc, int fr, int fq) const {
        const int row0 = u.pm * BM + wr * 64 + fr, col0 = u.pn * 128 + wc * 32 + 8 * fq;
#pragma unroll
        for (int ai = 0; ai < 2; ++ai)
#pragma unroll
            for (int m = 0; m < 4; ++m) { float o[8];
#pragma unroll
                for (int j = 0; j < 8; ++j) { const float g = acc[ai][0][m][j >> 2][j & 3], up = acc[ai][1][m][j >> 2][j & 3]; o[j] = g * __builtin_amdgcn_rcpf(1.f + __expf(-g)) * up; }
                u32x4 w; w.x = cvt_pk_bf16(o[0], o[1]); w.y = cvt_pk_bf16(o[2], o[3]); w.z = cvt_pk_bf16(o[4], o[5]); w.w = cvt_pk_bf16(o[6], o[7]);
                *(u32x4*)(H + (size_t)(row0 + ai * HALF + m * 16) * DE + col0) = w; }
    }
};
struct EpDown {
    static constexpr bool PERM = true;
    bf16_t* Y;
    __device__ __forceinline__ void operator()(acc_t& acc, const Unit& u, int wr, int wc, int fr, int fq) const {
        const int row0 = u.pm * BM + wr * 64 + fr, col0 = u.pn * BM + wc * 32 + 8 * fq;
#pragma unroll
        for (int ai = 0; ai < 2; ++ai)
#pragma unroll
            for (int m = 0; m < 4; ++m) { bf16_t* rowp = Y + (size_t)(row0 + ai * HALF + m * 16) * DM + col0;
#pragma unroll
                for (int bj = 0; bj < 2; ++bj) { const f32x4 v0 = acc[ai][bj][m][0], v1 = acc[ai][bj][m][1];
                    u32x4 w; w.x = cvt_pk_bf16(v0[0], v0[1]); w.y = cvt_pk_bf16(v0[2], v0[3]); w.z = cvt_pk_bf16(v1[0], v1[1]); w.w = cvt_pk_bf16(v1[2], v1[3]);
                    *(u32x4*)(rowp + bj * HALF) = w; } }
    }
};

struct MoeOrder {
    const LAS int* base;
    const int* cnt; const int* list; int ncol, G, c, gather; const char* A; const char* W; size_t estride, a_tstep, w_tstep;
    __device__ bool next(int i, Unit& u) const {
        const int ntile = base[NEXP] >> 8; const long L = (long)i * G + c; if (L >= (long)ntile * ncol) return false;
        const int rt = (int)(L / ncol), pn = (int)(L % ncol);
        int e = 0; while (e < NEXP - 1 && base[e + 1] <= rt * 256) ++e;
        u.pm = rt; u.pn = pn; u.e = e; const int r0 = rt * 256 - base[e];
        u.pad = cnt[e] - r0;
        u.arow = list + (size_t)e * T_TOK + r0;
        u.abase = gather ? A : A + (size_t)rt * a_tstep; u.bbase = W + (size_t)e * estride + (size_t)pn * w_tstep; return true;
    }
};
struct Args { const float* in[25]; float* out; unsigned char* ws; int ph_lo, ph_hi, li, pad; };
static_assert(sizeof(Args) == 27 * 8 + 16, "Args has no padding");

struct Frame {
    LAS unsigned char* lds; volatile LAS unsigned* MISC; unsigned* ctl;
    int tid, lane, wave, vcu, G;
};

__device__ __forceinline__ void transpose_item(const float* W, int ldw, int k0, int nsrc0, bf16_t* WT, size_t dst_row0, int ldt, int dst_k0, LAS float* scr, int lane) {
    f32x4 tv[8];
    { const float* wp = W + (size_t)(k0 + (lane >> 3)) * ldw + nsrc0 + 4 * (lane & 7);
#pragma unroll
        for (int i = 0; i < 8; ++i) tv[i] = *(const f32x4*)(wp + (size_t)(8 * i) * ldw);
#pragma unroll
        for (int i = 0; i < 8; ++i) { LAS float* sp = scr + (8 * i + (lane >> 3)) * 33 + 4 * (lane & 7); sp[0] = tv[i][0]; sp[1] = tv[i][1]; sp[2] = tv[i][2]; sp[3] = tv[i][3]; } }
    LDS_WAIT(); asm volatile("" ::: "memory");
    const int c = lane & 7;
#pragma unroll
    for (int j = 0; j < 4; ++j) { const int n = (lane >> 3) + 8 * j; const LAS float* s = scr + (8 * c) * 33 + n;
        u32x4 o; o.x = pk2(s[0 * 33], s[1 * 33]); o.y = pk2(s[2 * 33], s[3 * 33]); o.z = pk2(s[4 * 33], s[5 * 33]); o.w = pk2(s[6 * 33], s[7 * 33]);
        *(u32x4*)(WT + (dst_row0 + n) * ldt + dst_k0 + k0 + 8 * c) = o; }
    LDS_WAIT(); asm volatile("" ::: "memory");
}

__device__ __forceinline__ void p0_prologue(Frame& F, const Args& a) {
    unsigned char* ws = a.ws;
    const float* x = a.in[0]; const float* w_in = a.in[1]; const float* b_in = a.in[2]; const float* w_a = a.in[11]; const float* w_b = a.in[12]; const float* w_out = a.in[13];
    bf16_t* WIN_T = (bf16_t*)(ws + WS_WIN_T); bf16_t* WM_T = (bf16_t*)(ws + WS_WA_T); bf16_t* WOUT_T = (bf16_t*)(ws + WS_WOUT_T); bf16_t* XB = (bf16_t*)(ws + WS_XB); float* gates = (float*)(ws + WS_GATES);
    LAS float* scr = (LAS float*)(F.lds + F.wave * 8448);
    const int gw = F.vcu * NWAVES + F.wave, NGW = F.G * NWAVES;
    constexpr int I_IN = 32 * (N_MAIN / 32), I_B = 16 * 64, I_A = 16 * 64, I_O = 32 * 64;
    for (int it = gw; it < I_IN + I_B + I_A + I_O; it += NGW) {
        int r = it;
        if (r < I_IN) { const int kb = r / (N_MAIN / 32), nb = r % (N_MAIN / 32), n0 = nb * 32; transpose_item(w_in, N_IN, kb * 64, n0 + (n0 >= 4096 ? 8 : 0), WIN_T, n0, DM, 0, scr, F.lane); continue; } r -= I_IN;
        if (r < I_B) { const int kb = r / 64, nb = r % 64; transpose_item(w_b, DM, kb * 64, nb * 32, WM_T, nb * 32, DM, 0, scr, F.lane); continue; } r -= I_B;
        if (r < I_A) { const int kb = r / 64, nb = r % 64; transpose_item(w_a, DM, kb * 64, nb * 32, WM_T, nb * 32, DM, 1024, scr, F.lane); continue; } r -= I_A;
        { const int kb = r / 64, nb = r % 64; transpose_item(w_out, DM, kb * 64, nb * 32, WOUT_T, nb * 32, DM, 0, scr, F.lane); }
    }
    {
        const float* w_grp = a.in[16]; const float* w_exp = a.in[18]; bf16_t* WRH = (bf16_t*)(ws + WS_WRT); bf16_t* WRL = WRH + 48 * DM;
        for (int i = gw * 64 + F.lane; i < 48 * DM; i += NGW * 64) { const int n = i >> 11, k = i & (DM - 1);
            const float v = n < 4 ? w_grp[k * 4 + n] : (n < 36 ? w_exp[k * 32 + (n - 4)] : 0.f); const bf16_t hi = f2bf(v); WRH[i] = hi; WRL[i] = f2bf(v - bf2f(hi)); } }
    __syncthreads();
    LAS float* wgT = (LAS float*)F.lds;
    for (int i = F.tid; i < DM * 8; i += NWAVES * 64) { const int d = i >> 3, g = i & 7; wgT[g * DM + d] = w_in[(size_t)d * N_IN + 4096 + g]; }
    __syncthreads();
    for (int m = gw; m < T_TOK; m += NGW) {
        const float* xr = x + (size_t)m * DM; float acc[8];
#pragma unroll
        for (int g = 0; g < 8; ++g) acc[g] = 0.f;
        f32x4 xrow[8];
#pragma unroll
        for (int i = 0; i < 8; ++i) xrow[i] = *(const f32x4*)(xr + i * 256 + F.lane * 4);
#pragma unroll
        for (int i = 0; i < 8; ++i) { const int d0 = i * 256 + F.lane * 4; const f32x4 xv = xrow[i];
            u32x2 pk; pk.x = pk2(xv[0], xv[1]); pk.y = pk2(xv[2], xv[3]); *(u32x2*)(XB + (size_t)m * DM + d0) = pk;
            __builtin_amdgcn_sched_barrier(0);
#pragma unroll
            for (int g = 0; g < 8; ++g) { const f32x4 wv = *(const LAS f32x4*)(wgT + g * DM + d0); acc[g] += (xv[0] * wv[0] + xv[1] * wv[1]) + (xv[2] * wv[2] + xv[3] * wv[3]); } }
#pragma unroll
        for (int g = 0; g < 8; ++g) acc[g] = wsum(acc[g]);
        if (F.lane < 8) { float v = acc[0];
#pragma unroll
            for (int g = 1; g < 8; ++g) v = (F.lane == g) ? acc[g] : v;
            gates[(size_t)m * 8 + F.lane] = v + b_in[4096 + F.lane]; }
    }
}
__device__ __forceinline__ void moe_gu_copies(Frame& F, const Args& a) {
    unsigned char* ws = a.ws; const float* w_gate = a.in[20]; const float* w_up = a.in[21];
    bf16_t* WGU_T = (bf16_t*)(ws + WS_WGU_T);
    LAS float* scr = (LAS float*)(F.lds + F.wave * 8448);
    const int gw = F.vcu * NWAVES + F.wave, NGW = F.G * NWAVES;
    constexpr int I_G = NEXP * 32 * 16;
    for (int it = gw; it < 2 * I_G; it += NGW) { int r = it; const int up = r >= I_G; if (up) r -= I_G; const int e = r / 512, q = r % 512, kb = q / 16, nb = q % 16, n0 = nb * 32;
        transpose_item((up ? w_up : w_gate) + (size_t)e * DM * DE, DE, kb * 64, n0, WGU_T + (size_t)e * 1024 * DM, (n0 >> 7) * 256 + (n0 & 127) + (up ? 128 : 0), DM, 0, scr, F.lane); }
}
__device__ __forceinline__ void moe_down_copies_all(Frame& F, const Args& a) {
    unsigned char* ws = a.ws; const float* w_down = a.in[22]; bf16_t* WD_T = (bf16_t*)(ws + WS_WD_T);
    LAS float* scr = (LAS float*)(F.lds + F.wave * 8448);
    const int gw = F.vcu * NWAVES + F.wave, NGW = F.G * NWAVES;
    constexpr int I_D = NEXP * 8 * 64;
    for (int r = gw; r < I_D; r += NGW) { const int e = r / 512, q = r % 512, kb = q / 64, nb = q % 64;
        transpose_item(w_down + (size_t)e * DE * DM, DM, kb * 64, nb * 32, WD_T + (size_t)e * DM * DE, nb * 32, DE, 0, scr, F.lane); }
}

__device__ __forceinline__ void mlstm_rec_unit(Frame& F, const Args& a, int bh) {
    unsigned char* ws = a.ws; const bf16_t* ZA = (const bf16_t*)(ws + WS_ZA); const float* gates = (const float*)(ws + WS_GATES); bf16_t* HO = (bf16_t*)(ws + WS_XB);
    const float* conv_w = a.in[3]; const float* conv_b = a.in[4]; const float* norm_g = a.in[5];
    const int b = bh >> 2, h = bh & 3, tid = F.tid, j = tid & 255, kq = tid >> 8, lane = F.lane, wv = F.wave;
    LAS float* qs = (LAS float*)F.lds; LAS float* ks = qs + 256; LAS float* red = ks + 256; LAS float* sred = red + 512; LAS float* sred2 = sred + 8; LAS float* sred3 = sred2 + 8;
    float C[128];
#pragma unroll
    for (int i = 0; i < 128; ++i) C[i] = 0.f;
    float nreg = 0.f, m = 0.f;
    const int chan = (tid < 256) ? (h * 256 + tid) : (1024 + h * 256 + (tid - 256));
    const float cw0 = conv_w[chan], cw1 = conv_w[2048 + chan], cw2 = conv_w[4096 + chan], cw3 = conv_w[6144 + chan], cb = conv_b[chan];
    float z1 = 0, z2 = 0, z3 = 0;
    const float gch = norm_g[h * 256 + j];
    for (int t = 0; t < SEQ; ++t) {
        const size_t row = (size_t)b * SEQ + t;
        { const float zc = bf2f(ZA[row * 4096 + chan]); const float val = cw0 * z3 + cw1 * z2 + cw2 * z1 + cw3 * zc + cb; z3 = z2; z2 = z1; z1 = zc;
            const float s = val / (1.f + __expf(-val)); if (tid < 256) qs[tid] = s; else ks[tid - 256] = s * 0.0625f; }
        __syncthreads();
        const float ig = gates[row * 8 + h], fg = gates[row * 8 + 4 + h];
        const float lf = fminf(fg, 0.f) - log1pf(__expf(-fabsf(fg)));
        const float m_new = fmaxf(lf + m, ig), fd = __expf(lf + m - m_new), iw = __expf(ig - m_new); m = m_new;
        const float vj = bf2f(ZA[row * 4096 + 2048 + h * 256 + j]);
        float part = 0.f;
#pragma unroll
        for (int kk = 0; kk < 128; ++kk) { const int ki = kq * 128 + kk; C[kk] = fd * C[kk] + iw * ks[ki] * vj; part += qs[ki] * C[kk]; }
        red[kq * 256 + j] = part;
        float dpart = 0.f;
        if (tid < 256) { nreg = fd * nreg + iw * ks[tid]; dpart = qs[tid] * nreg; }
        dpart = wsum(dpart);
        if (tid < 256 && lane == 0) sred[wv] = dpart;
        __syncthreads();
        float hv = 0.f;
        if (tid < 256) { const float num = red[j] + red[256 + j]; const float den = sred[0] + sred[1] + sred[2] + sred[3];
            hv = sigm(bf2f(ZA[row * 4096 + 3072 + h * 256 + j])) * (num / fmaxf(fabsf(den), __expf(-m))); }
        const float s1 = wsum(hv);
        if (tid < 256 && lane == 0) sred2[wv] = s1;
        __syncthreads();
        const float mu = (sred2[0] + sred2[1] + sred2[2] + sred2[3]) * (1.f / 256.f);
        const float dv = (tid < 256) ? (hv - mu) : 0.f;
        const float s2 = wsum(dv * dv);
        if (tid < 256 && lane == 0) sred3[wv] = s2;
        __syncthreads();
        if (tid < 256) { const float var = (sred3[0] + sred3[1] + sred3[2] + sred3[3]) * (1.f / 256.f);
            HO[row * 2048 + 1024 + h * 256 + j] = f2bf(dv * rsqrtf(var + LN_EPS) * gch); }
    }
}
__device__ __forceinline__ void attn_simple_item(Frame& F, const Args& a, int idx, float lam) {
    unsigned char* ws = a.ws; const bf16_t* ZB = (const bf16_t*)(ws + WS_ZB); bf16_t* HO = (bf16_t*)(ws + WS_XB); const float* dng = a.in[10];
    const int lane = F.lane; LAS float* qs = (LAS float*)(F.lds + 8192) + F.wave * 128;
    const int t = idx & (SEQ - 1), h = (idx >> 12) & 7, b = idx >> 15;
    const size_t row = (size_t)b * SEQ + t;
    qs[lane] = bf2f(ZB[row * 3072 + h * 128 + lane]) * 0.125f;
    qs[64 + lane] = bf2f(ZB[row * 3072 + h * 128 + 64 + lane]) * 0.125f;
    LDS_WAIT(); asm volatile("" ::: "memory");
    const float slope = exp2f(-(float)(h + 1));
    const int kend = ((t >> 6) + 1) << 6;
    float m0 = -INFINITY, m1 = -INFINITY;
    for (int k0 = 0; k0 < kend; k0 += 64) {
        const int k = k0 + lane; const bf16_t* kp = ZB + ((size_t)b * SEQ + k) * 3072 + 1024 + h * 128;
        float s0 = 0.f, s1 = 0.f;
#pragma unroll 8
        for (int d = 0; d < 64; ++d) { s0 += qs[d] * bf2f(kp[d]); s1 += qs[64 + d] * bf2f(kp[64 + d]); }
        const float bias = slope * fabsf((float)(t - k)); s0 -= bias; s1 -= bias;
        m0 = fmaxf(m0, s0); m1 = fmaxf(m1, s1);
    }
    m0 = wmaxf(m0); m1 = wmaxf(m1);
    float l0 = 0.f, l1 = 0.f, a00 = 0.f, a01 = 0.f, a10 = 0.f, a11 = 0.f;
    for (int k0 = 0; k0 < kend; k0 += 64) {
        const int k = k0 + lane; const bf16_t* kp = ZB + ((size_t)b * SEQ + k) * 3072 + 1024 + h * 128;
        float s0 = 0.f, s1 = 0.f;
#pragma unroll 8
        for (int d = 0; d < 64; ++d) { s0 += qs[d] * bf2f(kp[d]); s1 += qs[64 + d] * bf2f(kp[64 + d]); }
        const float bias = slope * fabsf((float)(t - k)); s0 -= bias; s1 -= bias;
        const float p0 = __expf(s0 - m0), p1 = __expf(s1 - m1); l0 += p0; l1 += p1;
        for (int kk = 0; kk < 64; ++kk) { const float c0 = __shfl(p0, kk), c1 = __shfl(p1, kk);
            const bf16_t* vr = ZB + ((size_t)b * SEQ + k0 + kk) * 3072 + 2048 + h * 128;
            const float v0 = bf2f(vr[lane]), v1 = bf2f(vr[64 + lane]);
            a00 += c0 * v0; a01 += c0 * v1; a10 += c1 * v0; a11 += c1 * v1; }
    }
    l0 = wsum(l0); l1 = wsum(l1);
    const float olo = a00 / l0 - lam * a10 / l1, ohi = a01 / l0 - lam * a11 / l1;
    const float ms = wsum(olo * olo + ohi * ohi) * (1.f / 128.f);
    const float r = rsqrtf(ms + LN_EPS) * (1.f - LAMBDA_INIT);
    HO[row * 2048 + h * 128 + lane] = f2bf(olo * r * dng[lane]);
    HO[row * 2048 + h * 128 + 64 + lane] = f2bf(ohi * r * dng[64 + lane]);
    LDS_WAIT(); asm volatile("" ::: "memory");
}
constexpr int L1_STR = 528, L1_HI = 0, L1_LO = 64 * L1_STR, L1_ST = 2 * 64 * L1_STR, L1_WH = L1_ST + 1024, L1_WL = L1_WH + 48 * L1_STR, L1_END = L1_WL + 48 * L1_STR, L1_PART = L1_WH;
static_assert(L1_END <= RING_BYTES && 64 * 48 * 4 <= 2 * 48 * L1_STR, "LN1 unit LDS");
__device__ __forceinline__ void ln1_route_unit(Frame& F, const Args& a, int unit) {
    unsigned char* ws = a.ws; const bf16_t* R = (const bf16_t*)(ws + WS_R); bf16_t* X1B = (bf16_t*)(ws + WS_X1B);
    const float* g1 = a.in[14]; const float* b1 = a.in[15]; const float* b_grp = a.in[17]; const float* b_exp = a.in[19];
    const bf16_t* WRH = (const bf16_t*)(ws + WS_WRT); const bf16_t* WRL = WRH + 48 * DM;
    int* cnt = (int*)(ws + WS_CTL) + CW_CNT; int* list = (int*)(ws + WS_LIST); int* tok_e = (int*)(ws + WS_TOKE); int* tok_pos = (int*)(ws + WS_TOKP); float* tok_w = (float*)(ws + WS_TOKW);
    const int lane = F.lane, w = F.wave, tid = F.tid; LAS unsigned char* lds = F.lds;
    LAS float* sSt = (LAS float*)(lds + L1_ST);
    LAS float* sPart = (LAS float*)(lds + L1_PART);
    const int row0 = unit * 64;
    if (tid < 64) { const float* st = (const float*)(ws + WS_CTL) + CW_STATS + 2 * (row0 + tid); const float mu = st[0] * (1.f / DM); const float var = fmaxf(st[1] * (1.f / DM) - mu * mu, 0.f);
        sSt[2 * tid] = mu; sSt[2 * tid + 1] = rsqrtf(var + LN_EPS); }
    const int mt = w & 3, kh = w >> 2;
    f32x4 acc[3]; acc[0] = (f32x4){0.f, 0.f, 0.f, 0.f}; acc[1] = acc[0]; acc[2] = acc[0];
    const int fo = (lane & 15) * L1_STR + 16 * (lane >> 4);
    u32x4 wpre[6];
#define L1_WLOAD(ch) do { _Pragma("unroll") for (int _i = 0; _i < 6; ++_i) { const int _p = tid + 512 * _i, _img = _p / 1536, _q = _p % 1536, _r = _q >> 5, _c = _q & 31; \
        wpre[_i] = *(const u32x4*)((_img ? WRL : WRH) + (size_t)_r * DM + (ch) * 256 + _c * 8); } } while (0)
#define L1_WSTORE() do { _Pragma("unroll") for (int _i = 0; _i < 6; ++_i) { const int _p = tid + 512 * _i, _img = _p / 1536, _q = _p % 1536, _r = _q >> 5, _c = _q & 31; \
        *(LAS u32x4*)(lds + (_img ? L1_WL : L1_WH) + _r * L1_STR + _c * 16) = wpre[_i]; } } while (0)
    u32x2 rv[8];
#pragma unroll
    for (int i = 0; i < 8; ++i) rv[i] = *(const u32x2*)(R + (size_t)(row0 + 8 * w + i) * DM + 4 * lane);
    L1_WLOAD(0);
    __syncthreads();
#pragma unroll 1
    for (int ch = 0; ch < 8; ++ch) {
        const int k0 = ch * 256 + 4 * lane; const f32x4 gg = *(const f32x4*)(g1 + k0), bb = *(const f32x4*)(b1 + k0);
        L1_WSTORE();
        if (ch < 7) L1_WLOAD(ch + 1);
#pragma unroll
        for (int i = 0; i < 8; ++i) { const int r = 8 * w + i; const bf16_t* rr = R + (size_t)(row0 + r) * DM + k0; const float mu = sSt[2 * r], rstd = sSt[2 * r + 1];
            const f32x4 rf = (f32x4){__uint_as_float(rv[i].x << 16), __uint_as_float(rv[i].x & 0xffff0000u), __uint_as_float(rv[i].y << 16), __uint_as_float(rv[i].y & 0xffff0000u)};
            const f32x4 xv = (rf - mu) * rstd * gg + bb;
            if (ch < 7) rv[i] = *(const u32x2*)(rr + 256);
            u32x2 hi; hi.x = pk2(xv[0], xv[1]); hi.y = pk2(xv[2], xv[3]); *(u32x2*)(X1B + (size_t)(row0 + r) * DM + k0) = hi;
            u32x2 lo; lo.x = pk2(xv[0] - __uint_as_float(hi.x << 16), xv[1] - __uint_as_float(hi.x & 0xffff0000u)); lo.y = pk2(xv[2] - __uint_as_float(hi.y << 16), xv[3] - __uint_as_float(hi.y & 0xffff0000u));
            *(LAS u32x2*)(lds + L1_HI + r * L1_STR + 8 * lane) = hi; *(LAS u32x2*)(lds + L1_LO + r * L1_STR + 8 * lane) = lo; }
        __syncthreads();
#pragma unroll
        for (int kk = 0; kk < 4; ++kk) { const int ks = 4 * kh + kk;
            const bf16x8 ah = *(const LAS bf16x8*)(lds + L1_HI + 16 * mt * L1_STR + fo + 64 * ks), al = *(const LAS bf16x8*)(lds + L1_LO + 16 * mt * L1_STR + fo + 64 * ks);
#pragma unroll
            for (int nt = 0; nt < 3; ++nt) { const bf16x8 bh = *(const LAS bf16x8*)(lds + L1_WH + 16 * nt * L1_STR + fo + 64 * ks), bl = *(const LAS bf16x8*)(lds + L1_WL + 16 * nt * L1_STR + fo + 64 * ks);
                acc[nt] = __builtin_amdgcn_mfma_f32_16x16x32_bf16(ah, bh, acc[nt], 0, 0, 0);
                acc[nt] = __builtin_amdgcn_mfma_f32_16x16x32_bf16(al, bh, acc[nt], 0, 0, 0);
                acc[nt] = __builtin_amdgcn_mfma_f32_16x16x32_bf16(ah, bl, acc[nt], 0, 0, 0); } }
        __syncthreads();
    }
#undef L1_WLOAD
#undef L1_WSTORE
    if (kh == 1) {
#pragma unroll
        for (int nt = 0; nt < 3; ++nt)
#pragma unroll
            for (int r = 0; r < 4; ++r) sPart[(16 * mt + 4 * (lane >> 4) + r) * 48 + 16 * nt + (lane & 15)] = acc[nt][r]; }
    __syncthreads();
    if (kh == 0) {
#pragma unroll
        for (int nt = 0; nt < 3; ++nt)
#pragma unroll
            for (int r = 0; r < 4; ++r) sPart[(16 * mt + 4 * (lane >> 4) + r) * 48 + 16 * nt + (lane & 15)] += acc[nt][r]; }
    __syncthreads();
    if (tid < 64 && a.pad != 108) { const int row = row0 + tid; const LAS float* lg = sPart + tid * 48;
        float gl[4]; int gs = 0; float gm = -INFINITY;
#pragma unroll
        for (int c = 0; c < 4; ++c) { gl[c] = lg[c] + b_grp[c]; if (gl[c] > gm) { gm = gl[c]; gs = c; } }
        float den = 0.f;
#pragma unroll
        for (int c = 0; c < 4; ++c) den += __expf(gl[c] - gm);
        const float gp = 1.f / den;
        float v0 = -INFINITY, v1 = -INFINITY; int i0 = 0, i1 = 0;
#pragma unroll
        for (int j = 0; j < 8; ++j) { const int c = gs * 8 + j; const float val = lg[4 + c] + b_exp[c];
            if (val > v0) { v1 = v0; i1 = i0; v0 = val; i0 = c; } else if (val > v1) { v1 = val; i1 = c; } }
        const float w0 = 1.f / (1.f + __expf(v1 - v0)), w1 = 1.f - w0;
        const int p0 = atomicAdd(&cnt[i0], 1), p1 = atomicAdd(&cnt[i1], 1);
        list[i0 * T_TOK + p0] = row; list[i1 * T_TOK + p1] = row;
        tok_e[row * 2] = i0; tok_e[row * 2 + 1] = i1; tok_pos[row * 2] = p0; tok_pos[row * 2 + 1] = p1; tok_w[row * 2] = gp * w0; tok_w[row * 2 + 1] = gp * w1; }
    __syncthreads();
}
__device__ __forceinline__ void ln2_row(Frame& F, const Args& a, int row, const LAS int* base) {
    unsigned char* ws = a.ws; const bf16_t* X1 = (const bf16_t*)(ws + WS_R); const bf16_t* Y = (const bf16_t*)(ws + WS_Y);
    const int* tok_e = (const int*)(ws + WS_TOKE); const int* tok_pos = (const int*)(ws + WS_TOKP); const float* tok_w = (const float*)(ws + WS_TOKW);
    const float* g2 = a.in[23]; const float* b2 = a.in[24]; float* out = a.out; const int lane = F.lane;
    const size_t r0 = (size_t)(base[tok_e[row * 2]] + tok_pos[row * 2]) * DM, r1 = (size_t)(base[tok_e[row * 2 + 1]] + tok_pos[row * 2 + 1]) * DM;
    const float w0 = tok_w[row * 2], w1 = tok_w[row * 2 + 1];
    const float* g1 = a.in[14]; const float* b1 = a.in[15]; const float* st1 = (const float*)(ws + WS_CTL) + CW_STATS + 2 * row;
    const float mu1 = st1[0] * (1.f / DM), rstd1 = rsqrtf(fmaxf(st1[1] * (1.f / DM) - mu1 * mu1, 0.f) + LN_EPS);
    f32x4 v[8]; float s = 0.f;
#pragma unroll
    for (int i = 0; i < 8; ++i) { const int d0 = i * 256 + lane * 4; const u32x2 rw = *(const u32x2*)(X1 + (size_t)row * DM + d0);
        const f32x4 rf = (f32x4){__uint_as_float(rw.x << 16), __uint_as_float(rw.x & 0xffff0000u), __uint_as_float(rw.y << 16), __uint_as_float(rw.y & 0xffff0000u)};
        const f32x4 xv = (rf - mu1) * rstd1 * *(const f32x4*)(g1 + d0) + *(const f32x4*)(b1 + d0);
        const u32x2 y0 = *(const u32x2*)(Y + r0 + d0), y1 = *(const u32x2*)(Y + r1 + d0);
        f32x4 t;
        t[0] = ALPHA * xv[0] + w0 * __uint_as_float(y0.x << 16) + w1 * __uint_as_float(y1.x << 16);
        t[1] = ALPHA * xv[1] + w0 * __uint_as_float(y0.x & 0xffff0000u) + w1 * __uint_as_float(y1.x & 0xffff0000u);
        t[2] = ALPHA * xv[2] + w0 * __uint_as_float(y0.y << 16) + w1 * __uint_as_float(y1.y << 16);
        t[3] = ALPHA * xv[3] + w0 * __uint_as_float(y0.y & 0xffff0000u) + w1 * __uint_as_float(y1.y & 0xffff0000u);
        v[i] = t; s += (t[0] + t[1]) + (t[2] + t[3]); }
    const float mu = wsum(s) * (1.f / DM); float q = 0.f;
#pragma unroll
    for (int i = 0; i < 8; ++i) { v[i] = v[i] - mu; q += (v[i][0] * v[i][0] + v[i][1] * v[i][1]) + (v[i][2] * v[i][2] + v[i][3] * v[i][3]); }
    const float rstd = rsqrtf(wsum(q) * (1.f / DM) + LN_EPS);
#pragma unroll
    for (int i = 0; i < 8; ++i) { const int d0 = i * 256 + lane * 4; const f32x4 gg = *(const f32x4*)(g2 + d0), bb = *(const f32x4*)(b2 + d0);
        *(f32x4*)(out + (size_t)row * DM + d0) = v[i] * rstd * gg + bb; }
}
__device__ __forceinline__ void moe_base_to_lds(Frame& F, const Args& a, LAS int* base) {
    const int* cnt = (const int*)(a.ws + WS_CTL) + CW_CNT;
    if (F.tid == 0) { int acc = 0; for (int e = 0; e < NEXP; ++e) { base[e] = acc; acc += ((cnt[e] + 255) >> 8) << 8; } base[NEXP] = acc; }
    __syncthreads();
}
namespace att {
constexpr int KSTR = 256, VSTR = 256, KBYTES = 64 * KSTR, VBYTES = 64 * VSTR, BUF = KBYTES + VBYTES, NBUF = 4;
constexpr float LOG2E = 1.4426950408889634f;
typedef short v4i16_t __attribute__((ext_vector_type(4)));

__device__ __forceinline__ void unit(Frame& F, const Args& a, int b, int h, int qb, float lam, const LAS float* dngl  ) {
    unsigned char* ws = a.ws; const bf16_t* ZB = (const bf16_t*)(ws + WS_ZB); bf16_t* HO = (bf16_t*)(ws + WS_XB);
    const int tid = F.tid, lane = F.lane, w = F.wave, r32 = lane & 31, hi = lane >> 5, mp = w >> 2, wq = w & 3;
    LAS unsigned char* lds = F.lds;
    const int q0 = qb * 128 + wq * 32;
    const int qpos = q0 + r32;
    const int ntile = 2 * qb + 2;
    const int ntw = (q0 >> 6) + 1;
    const size_t rowb = (size_t)b * SEQ;
    const float slope = exp2f(-(float)(h + 1));
    bf16x8 qf[4];
    { const bf16_t* qp = ZB + (rowb + qpos) * 3072 + h * 128 + mp * 64 + 8 * hi;
#pragma unroll
        for (int ks = 0; ks < 4; ++ks) { const u32x4 raw = *(const u32x4*)(qp + 16 * ks); float f[8]; unpack8(raw, f);
            u32x4 o; o.x = pk2(f[0] * 0.125f, f[1] * 0.125f); o.y = pk2(f[2] * 0.125f, f[3] * 0.125f); o.z = pk2(f[4] * 0.125f, f[5] * 0.125f); o.w = pk2(f[6] * 0.125f, f[7] * 0.125f);
            qf[ks] = __builtin_bit_cast(bf16x8, o); } }
    unsigned gofs[4];
#pragma unroll
    for (int jj = 0; jj < 2; ++jj) { const int r = 8 * w + 4 * jj + (lane >> 4), cp = lane & 15;
        gofs[jj] = (unsigned)(((size_t)r * 3072 + 1024 + h * 128 + ((cp ^ (r & 15)) * 8)) * 2);
        gofs[2 + jj] = (unsigned)(((size_t)r * 3072 + 2048 + h * 128 + ((cp ^ ((r & 3) << 2)) * 8)) * 2); }
    const char* gtile = (const char*)(ZB + rowb * 3072);
#define ATT_GLDS(gp, ldst) do { unsigned _keep; asm volatile("s_mov_b32 %0, m0\n\ts_mov_b32 m0, %2\n\ts_nop 0\n\tglobal_load_lds_dwordx4 %1, off\n\ts_mov_b32 m0, %0" \
        : "=&s"(_keep) : "v"(gp), "s"(ldst) : "memory"); } while (0)
    const unsigned ldsb = (unsigned)(uintptr_t)lds + (unsigned)w * 2048u;
#define ATT_DMA(tt, bfi) do { const char* _g = gtile + (size_t)(tt) * (64 * 3072 * 2); const unsigned _l = (unsigned)__builtin_amdgcn_readfirstlane((int)(ldsb + (unsigned)(bfi) * BUF)); \
        ATT_GLDS(_g + gofs[0], _l); ATT_GLDS(_g + gofs[1], _l + 1024u); ATT_GLDS(_g + gofs[2], _l + (unsigned)KBYTES); ATT_GLDS(_g + gofs[3], _l + (unsigned)KBYTES + 1024u); } while (0)
    f32x16 oacc[4];
#pragma unroll
    for (int nb = 0; nb < 4; ++nb)
#pragma unroll
        for (int r = 0; r < 16; ++r) oacc[nb][r] = 0.f;
    const float sl4hi = slope * (float)(4 * hi);
    const float s32 = 32.f * slope;
    constexpr float THR = 6.0f;
    float m = -INFINITY, l = 0.f;
    const int krow = r32 * KSTR; int kx[4];
#pragma unroll
    for (int ks = 0; ks < 4; ++ks) kx[ks] = krow + (((mp * 8 + 2 * ks + hi) ^ (r32 & 15)) << 4);
    const int vq = (lane & 15) >> 2; int vo[4];
#pragma unroll
    for (int nb = 0; nb < 4; ++nb) vo[nb] = KBYTES + (4 * hi + vq) * VSTR + ((((nb ^ vq) << 2) + 2 * ((lane >> 4) & 1) + ((lane & 3) >> 1)) << 4) + (lane & 1) * 8;
#define ATT_TILE(seq) ((ntile - 1 - (seq)) > 0 ? (ntile - 1 - (seq)) : 0)
    ATT_DMA(ATT_TILE(0), 0); ATT_DMA(ATT_TILE(1), 1); ATT_DMA(ATT_TILE(2), 2);
    asm volatile("s_waitcnt vmcnt(8)\n\ts_barrier" ::: "memory");
    for (int it = 0; it < ntile; ++it) {
        const int t = ntile - 1 - it, bf = it & 3;
        ATT_DMA(ATT_TILE(it + 3), (it + 3) & 3);
        if (t < ntw && a.pad != 103) {
            LAS unsigned char* kb_ = lds + bf * BUF;
            f32x16 s0, s1;
            f32x16 bin;
            { float slo = slope; asm volatile("" : "+v"(slo));
#pragma unroll
                for (int r = 0; r < 16; ++r) bin[r] = slo * (float)((r & 3) + 8 * (r >> 2)) + sl4hi; }
            { bf16x8 kf0[2], kf1[2];
#pragma unroll
                for (int ks = 0; ks < 2; ++ks) { kf0[ks] = *(const LAS bf16x8*)(kb_ + kx[ks]); kf1[ks] = *(const LAS bf16x8*)(kb_ + kx[ks] + 32 * KSTR); }
                __builtin_amdgcn_sched_barrier(0);
                s0 = __builtin_amdgcn_mfma_f32_32x32x16_bf16(kf0[0], qf[0], bin, 0, 0, 0); s1 = __builtin_amdgcn_mfma_f32_32x32x16_bf16(kf1[0], qf[0], bin, 0, 0, 0);
                s0 = __builtin_amdgcn_mfma_f32_32x32x16_bf16(kf0[1], qf[1], s0, 0, 0, 0); s1 = __builtin_amdgcn_mfma_f32_32x32x16_bf16(kf1[1], qf[1], s1, 0, 0, 0);
                bf16x8 kg0[2], kg1[2];
#pragma unroll
                for (int ks = 0; ks < 2; ++ks) { kg0[ks] = *(const LAS bf16x8*)(kb_ + kx[ks + 2]); kg1[ks] = *(const LAS bf16x8*)(kb_ + kx[ks + 2] + 32 * KSTR); }
                s0 = __builtin_amdgcn_mfma_f32_32x32x16_bf16(kg0[0], qf[2], s0, 0, 0, 0); s1 = __builtin_amdgcn_mfma_f32_32x32x16_bf16(kg1[0], qf[2], s1, 0, 0, 0);
                s0 = __builtin_amdgcn_mfma_f32_32x32x16_bf16(kg0[1], qf[3], s0, 0, 0, 0); s1 = __builtin_amdgcn_mfma_f32_32x32x16_bf16(kg1[1], qf[3], s1, 0, 0, 0); }
            if (t == ntw - 1) {
                const float dq = (float)(qpos - t * 64); int hi4 = 4 * hi; asm volatile("" : "+v"(hi4));
#pragma unroll
                for (int r = 0; r < 16; ++r) { const float kk = (float)((r & 3) + 8 * (r >> 2) + hi4);
                    s0[r] += slope * (dq - fabsf(dq - kk) - kk); s1[r] += slope * (dq - fabsf(dq - (kk + 32.f)) - (kk + 32.f)); } }
            float mx0 = fmaxf(fmaxf(s0[0], s0[1]), s0[2]), mx1 = fmaxf(fmaxf(s1[0], s1[1]), s1[2]);
#pragma unroll
            for (int r = 3; r < 15; r += 2) { mx0 = fmaxf(fmaxf(mx0, s0[r]), s0[r + 1]); mx1 = fmaxf(fmaxf(mx1, s1[r]), s1[r + 1]); }
            mx0 = fmaxf(mx0, s0[15]); mx1 = fmaxf(mx1, s1[15]);
            const float ct = slope * (float)(t * 64);
            float mx = fmaxf(mx0, mx1 + s32) + ct;
            mx = fmaxf(mx, __shfl_xor(mx, 32));
            const bool dead = __all(mx - m < -104.f) || (a.pad == 102 && it > 0);
            if (!dead) {
            if (__any(mx > m + THR)) {
                const float m_new = fmaxf(m, mx); const float sc = __builtin_amdgcn_exp2f((m - m_new) * LOG2E); m = m_new; l *= sc;
#pragma unroll
                for (int nb = 0; nb < 4; ++nb)
#pragma unroll
                    for (int r = 0; r < 16; ++r) oacc[nb][r] *= sc;
            }
            const float c0 = (ct - m) * LOG2E, c1 = c0 + s32 * LOG2E;
            float ps = 0.f;
#pragma unroll
            for (int r = 0; r < 16; ++r) { s0[r] = __builtin_amdgcn_exp2f(s0[r] * LOG2E + c0); s1[r] = __builtin_amdgcn_exp2f(s1[r] * LOG2E + c1); ps += s0[r] + s1[r]; }
            l += ps;
            bf16x8 pf[2][2];
#pragma unroll
            for (int s = 0; s < 2; ++s) { u32x4 p0, p1;
                p0.x = cvt_pk_bf16(s0[8 * s + 0], s0[8 * s + 1]); p0.y = cvt_pk_bf16(s0[8 * s + 2], s0[8 * s + 3]); p0.z = cvt_pk_bf16(s0[8 * s + 4], s0[8 * s + 5]); p0.w = cvt_pk_bf16(s0[8 * s + 6], s0[8 * s + 7]);
                p1.x = cvt_pk_bf16(s1[8 * s + 0], s1[8 * s + 1]); p1.y = cvt_pk_bf16(s1[8 * s + 2], s1[8 * s + 3]); p1.z = cvt_pk_bf16(s1[8 * s + 4], s1[8 * s + 5]); p1.w = cvt_pk_bf16(s1[8 * s + 6], s1[8 * s + 7]);
                pf[0][s] = __builtin_bit_cast(bf16x8, p0); pf[1][s] = __builtin_bit_cast(bf16x8, p1); }
            { v4i16_t lo[2][4], hh[2][4];
#define ATT_VRD(set, g) do { _Pragma("unroll") for (int nb = 0; nb < 4; ++nb) { \
                    lo[set][nb] = __builtin_amdgcn_ds_read_tr16_b64_v4i16((LAS v4i16_t*)(kb_ + vo[nb] + ((g) * 16) * VSTR)); \
                    hh[set][nb] = __builtin_amdgcn_ds_read_tr16_b64_v4i16((LAS v4i16_t*)(kb_ + vo[nb] + ((g) * 16 + 8) * VSTR)); } } while (0)
#define ATT_PV(set, g) do { _Pragma("unroll") for (int nb = 0; nb < 4; ++nb) { \
                    const bf16x8 vf = (bf16x8){lo[set][nb][0], lo[set][nb][1], lo[set][nb][2], lo[set][nb][3], hh[set][nb][0], hh[set][nb][1], hh[set][nb][2], hh[set][nb][3]}; \
                    oacc[nb] = __builtin_amdgcn_mfma_f32_32x32x16_bf16(vf, pf[(g) >> 1][(g) & 1], oacc[nb], 0, 0, 0); } } while (0)
                ATT_VRD(0, 0); __builtin_amdgcn_sched_barrier(0);
                ATT_VRD(1, 1); __builtin_amdgcn_sched_barrier(0); ATT_PV(0, 0); __builtin_amdgcn_sched_barrier(0);
                ATT_VRD(0, 2); __builtin_amdgcn_sched_barrier(0); ATT_PV(1, 1); __builtin_amdgcn_sched_barrier(0);
                ATT_VRD(1, 3); __builtin_amdgcn_sched_barrier(0); ATT_PV(0, 2); __builtin_amdgcn_sched_barrier(0);
                ATT_PV(1, 3);
#undef ATT_VRD
#undef ATT_PV
            }
            }
        }
        asm volatile("s_waitcnt vmcnt(8) lgkmcnt(0)\n\ts_barrier" ::: "memory");
    }
    asm volatile("s_waitcnt vmcnt(0)\n\ts_barrier" ::: "memory");
#undef ATT_TILE
#undef ATT_DMA
#undef ATT_GLDS
    l += __shfl_xor(l, 32);
    const float inv = 1.f / l;
    LAS float* xb = (LAS float*)(lds + wq * 16384);
    if (mp == 1) {
#pragma unroll
        for (int nb = 0; nb < 4; ++nb)
#pragma unroll
            for (int r = 0; r < 16; ++r) xb[(nb * 16 + r) * 64 + lane] = oacc[nb][r] * inv;
    }
    __syncthreads();
    if (mp == 0) {
        float ss = 0.f;
#pragma unroll
        for (int nb = 0; nb < 4; ++nb) {
#pragma unroll
            for (int r = 0; r < 16; ++r) { const float o = oacc[nb][r] * inv - lam * xb[(nb * 16 + r) * 64 + lane]; oacc[nb][r] = o; ss += o * o; }
            __builtin_amdgcn_sched_barrier(0); }
        ss += __shfl_xor(ss, 32);
        const float rs = rsqrtf(ss * (1.f / 128.f) + LN_EPS) * (1.f - LAMBDA_INIT);
        bf16_t* op = HO + (rowb + qpos) * 2048 + h * 128 + 4 * hi;
#pragma unroll
        for (int nb = 0; nb < 4; ++nb)
#pragma unroll
            for (int g = 0; g < 4; ++g) { const int dv = nb * 32 + 8 * g; const f32x4 gg = *(const LAS f32x4*)(dngl + dv + 4 * hi);
                u32x2 o; o.x = pk2(oacc[nb][4 * g] * rs * gg[0], oacc[nb][4 * g + 1] * rs * gg[1]); o.y = pk2(oacc[nb][4 * g + 2] * rs * gg[2], oacc[nb][4 * g + 3] * rs * gg[3]);
                *(u32x2*)(op + dv) = o; }
    }
    __syncthreads();
}
}
namespace mls {
constexpr int KT_STR = 144;
constexpr int KT_BYTES = 256 * KT_STR;
constexpr int VTS_BYTES = 64 * KT_STR;
constexpr int SBUF = KT_BYTES + VTS_BYTES + 256;
constexpr size_t WS_MST = WS_SCAL;
constexpr size_t WS_NST = WS_SCAL + 65536;

__device__ __forceinline__ float silu_(float v) { return v * __builtin_amdgcn_rcpf(1.f + __expf(-v)); }
__device__ __forceinline__ float logsig_(float x) { return fminf(x, 0.f) - __logf(1.f + __expf(-fabsf(x))); }
__device__ __forceinline__ float lo16(unsigned u) { return __uint_as_float(u << 16); }
__device__ __forceinline__ float hi16(unsigned u) { return __uint_as_float(u & 0xffff0000u); }

__device__ __forceinline__ void chunk_scalars(const float ig, const float fg, int lane, float& bcs, float& a, float& cm) {
    float b = logsig_(fg);
#pragma unroll
    for (int o = 1; o < 64; o <<= 1) { const float t = __shfl_up(b, o); if (lane >= o) b += t; }
    a = ig - b; float c = a;
#pragma unroll
    for (int o = 1; o < 64; o <<= 1) { const float t = __shfl_up(c, o); if (lane >= o) c = fmaxf(c, t); }
    bcs = b; cm = c;
}

constexpr size_t WS_DNS = WS_SCAL + 65536;
constexpr size_t WS_AMX = WS_SCAL + 8192;
__device__ __forceinline__ void dc_unit(Frame& F, const Args& a_, int bh, int c) {
    unsigned char* ws = a_.ws; const bf16_t* ZA = (const bf16_t*)(ws + WS_ZA); const float* gates = (const float*)(ws + WS_GATES);
    bf16_t* CST = (bf16_t*)(ws + WS_CST); float* DNS = (float*)(ws + WS_DNS); float* AMX = (float*)(ws + WS_AMX);
    const float* conv_w = a_.in[3]; const float* conv_b = a_.in[4];
    const int b = bh >> 2, h = bh & 3, tid = F.tid, lane = F.lane, w = F.wave;
    const size_t rowb = (size_t)b * SEQ, row0 = rowb + (size_t)c * 64;
    LAS unsigned char* lds = F.lds;
    float bcs, av, cm; chunk_scalars(gates[(row0 + lane) * 8 + h], gates[(row0 + lane) * 8 + 4 + h], lane, bcs, av, cm);
    const float amax = __shfl(cm, 63), blast = __shfl(bcs, 63); const float wt = __expf(av - amax);
    if (tid == 0) { AMX[bh * 64 + c] = amax; AMX[1024 + bh * 64 + c] = blast; }
    { const int cp = tid & 127, sg = tid >> 7; const int kch = 1024 + h * 256 + 2 * cp;
        float cw[2][4], cb[2];
#pragma unroll
        for (int e = 0; e < 2; ++e) { cb[e] = conv_b[kch + e];
#pragma unroll
            for (int j = 0; j < 4; ++j) cw[e][j] = conv_w[j * 2048 + kch + e]; }
        unsigned kraw[19];
#pragma unroll
        for (int i = 0; i < 19; ++i) { const int t = c * 64 + 16 * sg - 3 + i; kraw[i] = (t >= 0) ? *(const unsigned*)(ZA + (rowb + t) * 4096 + kch) : 0u; }
        float o0[16], o1[16];
#pragma unroll
        for (int s = 0; s < 16; ++s) { const float ws_ = __shfl(wt, (16 * sg + s) & 63) * 0.0625f;
            const float v0 = cw[0][0] * lo16(kraw[s]) + cw[0][1] * lo16(kraw[s + 1]) + cw[0][2] * lo16(kraw[s + 2]) + cw[0][3] * lo16(kraw[s + 3]) + cb[0];
            const float v1 = cw[1][0] * hi16(kraw[s]) + cw[1][1] * hi16(kraw[s + 1]) + cw[1][2] * hi16(kraw[s + 2]) + cw[1][3] * hi16(kraw[s + 3]) + cb[1];
            o0[s] = silu_(v0) * ws_; o1[s] = silu_(v1) * ws_; }
        LAS unsigned char* p0 = lds + (2 * cp) * KT_STR + 32 * sg;
        u32x4 q;
        q.x = pk2(o0[0], o0[1]); q.y = pk2(o0[2], o0[3]); q.z = pk2(o0[4], o0[5]); q.w = pk2(o0[6], o0[7]); *(LAS u32x4*)p0 = q;
        q.x = pk2(o0[8], o0[9]); q.y = pk2(o0[10], o0[11]); q.z = pk2(o0[12], o0[13]); q.w = pk2(o0[14], o0[15]); *(LAS u32x4*)(p0 + 16) = q;
        q.x = pk2(o1[0], o1[1]); q.y = pk2(o1[2], o1[3]); q.z = pk2(o1[4], o1[5]); q.w = pk2(o1[6], o1[7]); *(LAS u32x4*)(p0 + KT_STR) = q;
        q.x = pk2(o1[8], o1[9]); q.y = pk2(o1[10], o1[11]); q.z = pk2(o1[12], o1[13]); q.w = pk2(o1[14], o1[15]); *(LAS u32x4*)(p0 + KT_STR + 16) = q; }
#pragma unroll
    for (int it = 0; it < 2; ++it) { const int item = tid + 512 * it, vp = item & 127, vg = item >> 7;
        unsigned r[8];
#pragma unroll
        for (int i = 0; i < 8; ++i) r[i] = *(const unsigned*)(ZA + (row0 + 8 * vg + i) * 4096 + 2048 + h * 256 + 2 * vp);
        u32x4 q0, q1;
        q0.x = (r[0] & 0xffffu) | (r[1] << 16); q0.y = (r[2] & 0xffffu) | (r[3] << 16); q0.z = (r[4] & 0xffffu) | (r[5] << 16); q0.w = (r[6] & 0xffffu) | (r[7] << 16);
        q1.x = (r[0] >> 16) | (r[1] & 0xffff0000u); q1.y = (r[2] >> 16) | (r[3] & 0xffff0000u); q1.z = (r[4] >> 16) | (r[5] & 0xffff0000u); q1.w = (r[6] >> 16) | (r[7] & 0xffff0000u);
        *(LAS u32x4*)(lds + KT_BYTES + (2 * vp) * KT_STR + 16 * vg) = q0; *(LAS u32x4*)(lds + KT_BYTES + (2 * vp + 1) * KT_STR + 16 * vg) = q1; }
    __syncthreads();
    if (tid < 256) { const LAS unsigned char* kr = lds + tid * KT_STR; float sacc = 0.f;
#pragma unroll
        for (int j = 0; j < 8; ++j) { float f[8]; unpack8(*(const LAS u32x4*)(kr + 16 * j), f); sacc += ((f[0] + f[1]) + (f[2] + f[3])) + ((f[4] + f[5]) + (f[6] + f[7])); }
        DNS[(size_t)(bh * 64 + c) * 256 + tid] = sacc; }
    { const int fo = (lane & 15) * KT_STR + 16 * (lane >> 4);
        bf16x8 A[2][2];
#pragma unroll
        for (int mt = 0; mt < 2; ++mt)
#pragma unroll
            for (int ks = 0; ks < 2; ++ks) A[mt][ks] = *(const LAS bf16x8*)(lds + (32 * w + 16 * mt) * KT_STR + fo + 64 * ks);
        bf16_t* cbase = CST + (size_t)(bh * 64 + c) * 65536 + 32 * w + 4 * (lane >> 4);
#pragma unroll
        for (int ng = 0; ng < 4; ++ng) {
            bf16x8 B[4][2];
#pragma unroll
            for (int nt = 0; nt < 4; ++nt)
#pragma unroll
                for (int ks = 0; ks < 2; ++ks) B[nt][ks] = *(const LAS bf16x8*)(lds + KT_BYTES + (64 * ng + 16 * nt) * KT_STR + fo + 64 * ks);
#pragma unroll
            for (int mt = 0; mt < 2; ++mt)
#pragma unroll
                for (int nt = 0; nt < 4; ++nt) { f32x4 acc = (f32x4){0.f, 0.f, 0.f, 0.f};
#pragma unroll
                    for (int ks = 0; ks < 2; ++ks) acc = __builtin_amdgcn_mfma_f32_16x16x32_bf16(A[mt][ks], B[nt][ks], acc, 0, 0, 0);
                    u32x2 q; q.x = pk2(acc[0], acc[1]); q.y = pk2(acc[2], acc[3]);
                    *(u32x2*)(cbase + (size_t)(64 * ng + 16 * nt + (lane & 15)) * 256 + 16 * mt) = q; } } }
    __syncthreads();
}

__device__ __forceinline__ void scan_item(Frame& F, const Args& a_, int bh, int part) {
    unsigned char* ws = a_.ws; bf16_t* CST = (bf16_t*)(ws + WS_CST); float* DNS = (float*)(ws + WS_DNS); const float* AMX = (const float*)(ws + WS_AMX); float* MST = (float*)(ws + WS_MST);
    const int tid = F.tid;
    LAS float* tb = (LAS float*)(F.lds);
    if (tid < 128) tb[tid] = AMX[(tid >> 6) * 1024 + bh * 64 + (tid & 63)];
    __syncthreads();
    u32x4* p = (u32x4*)(CST + (size_t)bh * 64 * 65536 + (size_t)part * 4096 + tid * 8);
    float st[8]; float nst = 0.f, m = 0.f;
#pragma unroll
    for (int e = 0; e < 8; ++e) st[e] = 0.f;
    const bool do_n = (part == 0) && (tid < 256);
    float* pn = DNS + (size_t)bh * 64 * 256 + tid;
    u32x4 d[8]; float dn[8];
#pragma unroll
    for (int i = 0; i < 8; ++i) { d[i] = p[(size_t)i * 8192]; dn[i] = do_n ? pn[i * 256] : 0.f; }
#pragma unroll 8
    for (int c = 0; c < 64; ++c) {
        const u32x4 dc = d[c & 7]; const float dnc = dn[c & 7];
        u32x4 o; o.x = pk2(st[0], st[1]); o.y = pk2(st[2], st[3]); o.z = pk2(st[4], st[5]); o.w = pk2(st[6], st[7]);
        p[(size_t)c * 8192] = o;
        if (do_n) pn[c * 256] = nst;
        if (part == 0 && tid == 0) MST[bh * 64 + c] = m;
        if (c + 8 < 64) { d[c & 7] = p[(size_t)(c + 8) * 8192]; dn[c & 7] = do_n ? pn[(c + 8) * 256] : 0.f; }
        const float amax = tb[c], Mx = fmaxf(m, amax), decay = __expf(m - Mx), g = __expf(amax - Mx);
        float f[8]; unpack8(dc, f);
#pragma unroll
        for (int e = 0; e < 8; ++e) st[e] = decay * st[e] + g * f[e];
        nst = decay * nst + g * dnc;
        m = tb[64 + c] + Mx;
    }
    __syncthreads();
}

constexpr int QSTR = 528;
constexpr int O_Q = 0, O_K = 64 * QSTR, O_VT = 2 * 64 * QSTR, O_P = O_VT + 256 * KT_STR, O_SC = O_P + 64 * KT_STR;
constexpr int O_END = O_SC + 4096;
static_assert(O_END <= RING_BYTES, "mLSTM output unit LDS");
__device__ __forceinline__ void out_unit(Frame& F, const Args& a_, int bh, int c) {
    unsigned char* ws = a_.ws; const bf16_t* ZA = (const bf16_t*)(ws + WS_ZA); const float* gates = (const float*)(ws + WS_GATES);
    const bf16_t* CST = (const bf16_t*)(ws + WS_CST); const float* MST = (const float*)(ws + WS_MST); const float* NST = (const float*)(ws + WS_NST); bf16_t* HO = (bf16_t*)(ws + WS_XB);
    const float* conv_w = a_.in[3]; const float* conv_b = a_.in[4]; const float* norm_g = a_.in[5];
    const int b = bh >> 2, h = bh & 3, tid = F.tid, lane = F.lane, w = F.wave;
    const size_t row0 = (size_t)b * SEQ + (size_t)c * 64;
    LAS unsigned char* lds = F.lds;
    LAS float* SC = (LAS float*)(lds + O_SC);
    LAS float* sA = SC, *sM = SC + 64, *sWi = SC + 128, *sEf = SC + 192, *sQn = SC + 256, *sRs = SC + 320, *sSt = SC + 448;
    const float m0 = MST[bh * 64 + c];
    if (w == 0) { float bcs, av, cm; chunk_scalars(gates[(row0 + lane) * 8 + h], gates[(row0 + lane) * 8 + 4 + h], lane, bcs, av, cm); const float M = fmaxf(m0, cm);
        sA[lane] = av; sM[lane] = M; sWi[lane] = __expf(m0 - M); sEf[lane] = __expf(-(bcs + M)); }
    { const int cg = tid & 31, pg = tid >> 5;
#pragma unroll
        for (int mat = 0; mat < 2; ++mat) {
            const int ch0 = mat * 1024 + h * 256 + 8 * cg;
            float cwv[4][8], cbv[8];
#pragma unroll
            for (int j = 0; j < 4; ++j) { const f32x4 x0 = *(const f32x4*)(conv_w + j * 2048 + ch0), x1 = *(const f32x4*)(conv_w + j * 2048 + ch0 + 4);
                cwv[j][0] = x0[0]; cwv[j][1] = x0[1]; cwv[j][2] = x0[2]; cwv[j][3] = x0[3]; cwv[j][4] = x1[0]; cwv[j][5] = x1[1]; cwv[j][6] = x1[2]; cwv[j][7] = x1[3]; }
            { const f32x4 x0 = *(const f32x4*)(conv_b + ch0), x1 = *(const f32x4*)(conv_b + ch0 + 4);
                cbv[0] = x0[0]; cbv[1] = x0[1]; cbv[2] = x0[2]; cbv[3] = x0[3]; cbv[4] = x1[0]; cbv[5] = x1[1]; cbv[6] = x1[2]; cbv[7] = x1[3]; }
            float z[7][8];
#pragma unroll
            for (int i = 0; i < 7; ++i) { const int t = c * 64 + 4 * pg - 3 + i;
                if (t >= 0) { unpack8(*(const u32x4*)(ZA + ((size_t)b * SEQ + t) * 4096 + ch0), z[i]); } else {
#pragma unroll
                    for (int e = 0; e < 8; ++e) z[i][e] = 0.f; } }
            const float scl = mat ? 0.0625f : 1.f;
#pragma unroll
            for (int s = 0; s < 4; ++s) { float o[8];
#pragma unroll
                for (int e = 0; e < 8; ++e) o[e] = silu_(cwv[0][e] * z[s][e] + cwv[1][e] * z[s + 1][e] + cwv[2][e] * z[s + 2][e] + cwv[3][e] * z[s + 3][e] + cbv[e]) * scl;
                u32x4 q; q.x = pk2(o[0], o[1]); q.y = pk2(o[2], o[3]); q.z = pk2(o[4], o[5]); q.w = pk2(o[6], o[7]);
                *(LAS u32x4*)(lds + (mat ? O_K : O_Q) + (4 * pg + s) * QSTR + 16 * cg) = q; }
        } }
#pragma unroll
    for (int it = 0; it < 2; ++it) { const int item = tid + 512 * it, vp = item & 127, vg = item >> 7;
        unsigned r[8];
#pragma unroll
        for (int i = 0; i < 8; ++i) r[i] = *(const unsigned*)(ZA + (row0 + 8 * vg + i) * 4096 + 2048 + h * 256 + 2 * vp);
        u32x4 q0, q1;
        q0.x = (r[0] & 0xffffu) | (r[1] << 16); q0.y = (r[2] & 0xffffu) | (r[3] << 16); q0.z = (r[4] & 0xffffu) | (r[5] << 16); q0.w = (r[6] & 0xffffu) | (r[7] << 16);
        q1.x = (r[0] >> 16) | (r[1] & 0xffff0000u); q1.y = (r[2] >> 16) | (r[3] & 0xffff0000u); q1.z = (r[4] >> 16) | (r[5] & 0xffff0000u); q1.w = (r[6] >> 16) | (r[7] & 0xffff0000u);
        *(LAS u32x4*)(lds + O_VT + (2 * vp) * KT_STR + 16 * vg) = q0; *(LAS u32x4*)(lds + O_VT + (2 * vp + 1) * KT_STR + 16 * vg) = q1; }
    __syncthreads();
    { const int mt = w >> 1; const int fo = (lane & 15) * QSTR + 16 * (lane >> 4);
        f32x4 s[2]; s[0] = (f32x4){0.f, 0.f, 0.f, 0.f}; s[1] = s[0];
#pragma unroll
        for (int ks = 0; ks < 8; ++ks) { const bf16x8 A = *(const LAS bf16x8*)(lds + O_Q + 16 * mt * QSTR + fo + 64 * ks);
#pragma unroll
            for (int j = 0; j < 2; ++j) { const int nt = (w & 1) * 2 + j; const bf16x8 B = *(const LAS bf16x8*)(lds + O_K + 16 * nt * QSTR + fo + 64 * ks);
                s[j] = __builtin_amdgcn_mfma_f32_16x16x32_bf16(A, B, s[j], 0, 0, 0); } }
        float rsum[4] = {0.f, 0.f, 0.f, 0.f};
#pragma unroll
        for (int j = 0; j < 2; ++j) { const int nt = (w & 1) * 2 + j, sp = 16 * nt + (lane & 15); const float as = sA[sp];
#pragma unroll
            for (int r = 0; r < 4; ++r) { const int t = 16 * mt + 4 * (lane >> 4) + r; const float d = (sp <= t) ? __expf(as - sM[t]) : 0.f; const float p = s[j][r] * d; rsum[r] += p;
                *(LAS bf16_t*)(lds + O_P + t * KT_STR + 2 * sp) = f2bf(p); } }
#pragma unroll
        for (int r = 0; r < 4; ++r) { float v = rsum[r]; v += __shfl_xor(v, 1); v += __shfl_xor(v, 2); v += __shfl_xor(v, 4); v += __shfl_xor(v, 8);
            if ((lane & 15) == 0) sRs[(16 * mt + 4 * (lane >> 4) + r) * 2 + (w & 1)] = v; }
        const f32x4 nv = *(const f32x4*)(NST + (size_t)(bh * 64 + c) * 256 + 4 * lane);
#pragma unroll
        for (int i = 0; i < 8; ++i) { const int t = 8 * w + i; const u32x2 qq = *(const LAS u32x2*)(lds + O_Q + t * QSTR + 8 * lane);
            float v = lo16(qq.x) * nv[0] + hi16(qq.x) * nv[1] + lo16(qq.y) * nv[2] + hi16(qq.y) * nv[3]; v = wsum(v); if (lane == 0) sQn[t] = v; }
    }
    __syncthreads();
    const int mt = w & 3, nq = w >> 2;
    f32x4 acc[4][2];
#pragma unroll
    for (int sl = 0; sl < 4; ++sl) { acc[sl][0] = (f32x4){0.f, 0.f, 0.f, 0.f}; acc[sl][1] = acc[sl][0]; }
    { const bf16_t* cbase = CST + (size_t)(bh * 64 + c) * 65536;
        const int fo = (lane & 15) * QSTR + 16 * (lane >> 4);
        u32x4 pre[4];
#define CT_LOAD(sl) do { _Pragma("unroll") for (int _i = 0; _i < 4; ++_i) { const int _ch = tid + 512 * _i; pre[_i] = *(const u32x4*)(cbase + (size_t)((sl) * 64 + (_ch >> 5)) * 256 + (_ch & 31) * 8); } } while (0)
#define CT_STORE() do { _Pragma("unroll") for (int _i = 0; _i < 4; ++_i) { const int _ch = tid + 512 * _i; *(LAS u32x4*)(lds + O_K + (_ch >> 5) * QSTR + (_ch & 31) * 16) = pre[_i]; } } while (0)
        CT_LOAD(0);
#pragma unroll
        for (int sl = 0; sl < 4; ++sl) {
            CT_STORE();
            if (sl < 3) CT_LOAD(sl + 1);
            __syncthreads();
#pragma unroll
            for (int ks = 0; ks < 8; ++ks) { const bf16x8 A = *(const LAS bf16x8*)(lds + O_Q + 16 * mt * QSTR + fo + 64 * ks);
#pragma unroll
                for (int j = 0; j < 2; ++j) { const bf16x8 B = *(const LAS bf16x8*)(lds + O_K + 16 * (2 * nq + j) * QSTR + fo + 64 * ks);
                    acc[sl][j] = __builtin_amdgcn_mfma_f32_16x16x32_bf16(A, B, acc[sl][j], 0, 0, 0); } }
            __syncthreads();
        }
#undef CT_LOAD
#undef CT_STORE
    }
    { float wi[4];
#pragma unroll
        for (int r = 0; r < 4; ++r) wi[r] = sWi[16 * mt + 4 * (lane >> 4) + r];
#pragma unroll
        for (int sl = 0; sl < 4; ++sl)
#pragma unroll
            for (int j = 0; j < 2; ++j)
#pragma unroll
                for (int r = 0; r < 4; ++r) acc[sl][j][r] *= wi[r];
        const int fo = (lane & 15) * KT_STR + 16 * (lane >> 4);
#pragma unroll
        for (int ks = 0; ks < 2; ++ks) { const bf16x8 A = *(const LAS bf16x8*)(lds + O_P + 16 * mt * KT_STR + fo + 64 * ks);
#pragma unroll
            for (int sl = 0; sl < 4; ++sl)
#pragma unroll
                for (int j = 0; j < 2; ++j) { const bf16x8 B = *(const LAS bf16x8*)(lds + O_VT + 16 * (4 * sl + 2 * nq + j) * KT_STR + fo + 64 * ks);
                    acc[sl][j] = __builtin_amdgcn_mfma_f32_16x16x32_bf16(A, B, acc[sl][j], 0, 0, 0); } }
    }
    { float s1[4] = {0.f, 0.f, 0.f, 0.f}, s2[4] = {0.f, 0.f, 0.f, 0.f};
#pragma unroll
        for (int r = 0; r < 4; ++r) { const int t = 16 * mt + 4 * (lane >> 4) + r; const float den = sWi[t] * sQn[t] + sRs[2 * t] + sRs[2 * t + 1];
            const float inv = __builtin_amdgcn_rcpf(fmaxf(fabsf(den), sEf[t]));
#pragma unroll
            for (int sl = 0; sl < 4; ++sl)
#pragma unroll
                for (int j = 0; j < 2; ++j) { const int dv = 16 * (4 * sl + 2 * nq + j) + (lane & 15);
                    const float og = bf2f(ZA[(row0 + t) * 4096 + 3072 + h * 256 + dv]);
                    const float hv = acc[sl][j][r] * inv * __builtin_amdgcn_rcpf(1.f + __expf(-og)); acc[sl][j][r] = hv; s1[r] += hv; s2[r] += hv * hv; } }
#pragma unroll
        for (int r = 0; r < 4; ++r) { float u = s1[r], v = s2[r];
            u += __shfl_xor(u, 1); u += __shfl_xor(u, 2); u += __shfl_xor(u, 4); u += __shfl_xor(u, 8);
            v += __shfl_xor(v, 1); v += __shfl_xor(v, 2); v += __shfl_xor(v, 4); v += __shfl_xor(v, 8);
            if ((lane & 15) == 0) { const int t = 16 * mt + 4 * (lane >> 4) + r; sSt[(t * 2 + nq) * 2] = u; sSt[(t * 2 + nq) * 2 + 1] = v; } }
    }
    __syncthreads();
    {
#pragma unroll
        for (int r = 0; r < 4; ++r) { const int t = 16 * mt + 4 * (lane >> 4) + r;
            const float su = sSt[t * 4] + sSt[t * 4 + 2], sq = sSt[t * 4 + 1] + sSt[t * 4 + 3];
            const float mu = su * (1.f / 256.f), var = fmaxf(sq * (1.f / 256.f) - mu * mu, 0.f), rstd = rsqrtf(var + LN_EPS);
#pragma unroll
            for (int sl = 0; sl < 4; ++sl)
#pragma unroll
                for (int j = 0; j < 2; ++j) { const int dv = 16 * (4 * sl + 2 * nq + j) + (lane & 15);
                    *(LAS bf16_t*)(lds + O_Q + t * QSTR + 2 * dv) = f2bf((acc[sl][j][r] - mu) * rstd * norm_g[h * 256 + dv]); } }
    }
    __syncthreads();
#pragma unroll
    for (int i = 0; i < 4; ++i) { const int ch = tid + 512 * i, t = ch >> 5, c16 = ch & 31;
        *(u32x4*)(HO + (row0 + t) * 2048 + 1024 + h * 256 + c16 * 8) = *(const LAS u32x4*)(lds + O_Q + t * QSTR + c16 * 16); }
    __syncthreads();
}
}
constexpr int N_PHASES = 11;
constexpr int CW_Q = 192;
constexpr int LDS_BASE_OFF = LDSCTL_OFF + 1024;

__global__ void __launch_bounds__(NWAVES * 64, 2) fwd(Args args) {
    __shared__ __attribute__((aligned(16))) unsigned char lds_raw[LDS_BYTES];
    Frame F;
    F.lds = (LAS unsigned char*)lds_raw;
    F.MISC = (volatile LAS unsigned*)(F.lds + MISC_OFF);
    F.tid = threadIdx.x; F.lane = F.tid & 63; F.wave = __builtin_amdgcn_readfirstlane(F.tid >> 6);
    F.G = gridDim.x; { const int bx = blockIdx.x; F.vcu = (F.G % 8 == 0) ? (bx % 8) * (F.G / 8) + bx / 8 : bx; }
    unsigned char* ws = args.ws;
    F.ctl = (unsigned*)(ws + WS_CTL);
    for (int u = F.tid; u < (LDS_BYTES - LDSCTL_OFF) / 4; u += NWAVES * 64) ((LAS unsigned*)(F.lds + LDSCTL_OFF))[u] = 0u;
    __syncthreads();
    const int lo = args.ph_lo, hi = args.ph_hi;
    XcdBarrier bar; bar.bar = F.ctl + CW_BAR + args.li * XCD_BAR_WORDS; bar.x = 0; bar.st = nullptr;
    if (hi - lo > 1) bar = xcd_barrier_post(F.ctl + CW_BAR + args.li * XCD_BAR_WORDS, F.MISC + 8, F.tid == 0);
#ifndef PHASE_MASK
#define PHASE_MASK 0x7ff
#endif
#define IN(k) ((((PHASE_MASK) >> (k)) & 1) && lo <= (k) && (k) < hi)
#ifndef BAR_REPS
#define BAR_REPS 1
#endif
#define SEAM(k) do { if (IN(k) && IN((k) + 1)) { for (int _b = 0; _b < BAR_REPS; ++_b) xcd_barrier(bar, F.wave); } } while (0)
    LAS int* lbase = (LAS int*)(F.lds + LDS_BASE_OFF);

#ifndef DUP_PHASE
#define DUP_PHASE (-1)
#endif
#define PHASE(k, BODY) do { if (IN(k)) { F.lane = (int)__builtin_amdgcn_mbcnt_hi(~0u, __builtin_amdgcn_mbcnt_lo(~0u, 0u)); F.tid = F.wave * 64 + F.lane;     \
        BODY(0); if (DUP_PHASE == (k)) { BODY(1); } SEAM(k); } } while (0)
#define PHASE_RT(k, BODY) do { if (IN(k)) { const int _nr = (args.pad == (k)) ? 2 : 1; for (int _rep = 0; _rep < _nr; ++_rep) { BODY(_rep); } SEAM(k); } } while (0)

#define BODY0(rep) do { p0_prologue(F, args); } while (0)
    PHASE(0, BODY0);

#define BODY1(rep) do { pg8::GridOrder S; S.init(ws + WS_XB, DM * 2, ws + WS_WIN_T, DM * 2, T_TOK, N_MAIN, F.G, (int)blockIdx.x); \
        EpIn E{args.in[2], (bf16_t*)(ws + WS_ZA), (bf16_t*)(ws + WS_ZB), (bf16_t*)(ws + WS_ZG)}; \
        pg8::gemm_phase<EpIn, pg8::GridOrder>(F.lds, F.tid, DM, DM * 2, DM * 2, S, E); } while (0)
    PHASE(1, BODY1);

#define BODY2(rep) do { for (int u = F.vcu; u < 1024; u += F.G) mls::dc_unit(F, args, u >> 6, u & 63); } while (0)
    PHASE(2, BODY2);

#define QNEXT(word, dst) do { if (F.tid == 0) *qslot = (int)__hip_atomic_fetch_add(F.ctl + (word), 1u, __ATOMIC_RELAXED, __HIP_MEMORY_SCOPE_AGENT); __syncthreads(); dst = *qslot; __syncthreads(); } while (0)
#define BODY3(rep) do { \
        volatile LAS int* qslot = (volatile LAS int*)(F.lds + LDS_BASE_OFF + 256); \
        const int qw = CW_Q + 64 * (rep) + 128 * args.li; \
        if (args.pad < 101) for (;;) { int item; QNEXT(qw, item); if (item >= 256) break; mls::scan_item(F, args, item >> 4, item & 15); } \
        if (args.pad != 100) { \
            const float lam = __expf(wsum(args.in[6][F.lane] * args.in[7][F.lane])) - __expf(wsum(args.in[8][F.lane] * args.in[9][F.lane])) + LAMBDA_INIT; \
            LAS float* dngl = (LAS float*)(F.lds + LDS_BASE_OFF + 512); if (F.tid < 128) dngl[F.tid] = args.in[10][F.tid]; __syncthreads(); \
            for (;;) { int P; QNEXT(qw + 32, P); if (P >= 512) break;         \
                const int bh = (((P >> 4) & 3) << 3) + (7 - (P >> 6)), pp = P & 15; \
                att::unit(F, args, bh >> 3, bh & 7, pp, lam, dngl); att::unit(F, args, bh >> 3, bh & 7, 31 - pp, lam, dngl); } } \
        } while (0)
    PHASE(3, BODY3);

#define BODY4(rep) do { for (int u = F.vcu; u < 1024; u += F.G) mls::out_unit(F, args, u >> 6, u & 63); } while (0)
    PHASE(4, BODY4);

#define BODY5(rep) do { pg8::GridOrder2K S; S.g.init(ws + WS_XB, DM * 2, ws + WS_WA_T, DM * 2, T_TOK, DM, F.G, (int)blockIdx.x); S.khalf_bytes = 1024 * 2; \
        EpMerge E{(const bf16_t*)(ws + WS_ZG), (bf16_t*)(ws + WS_MG)}; \
        pg8::gemm_phase<EpMerge, pg8::GridOrder2K, false, true>(F.lds, F.tid, 1024, DM * 2, DM * 2, S, E); } while (0)
    PHASE(5, BODY5);

#define BODY6(rep) do { pg8::GridOrder S; S.init(ws + WS_MG, DM * 2, ws + WS_WOUT_T, DM * 2, T_TOK, DM, F.G, (int)blockIdx.x); \
        EpOutR E{args.in[0], (bf16_t*)(ws + WS_R), (float*)(ws + WS_CTL) + CW_STATS}; \
        pg8::gemm_phase<EpOutR, pg8::GridOrder>(F.lds, F.tid, DM, DM * 2, DM * 2, S, E); } while (0)
    PHASE(6, BODY6);

#define BODY7(rep) do { if (args.pad != 107) for (int u = F.vcu; u < T_TOK / 64; u += F.G) ln1_route_unit(F, args, u); \
        if (args.pad != 108) { moe_gu_copies(F, args); moe_down_copies_all(F, args); } } while (0)
    if (IN(7)) { F.lane = (int)__builtin_amdgcn_mbcnt_hi(~0u, __builtin_amdgcn_mbcnt_lo(~0u, 0u)); F.tid = F.wave * 64 + F.lane; BODY7(0); SEAM(7); }

#define BODY8(rep) do { moe_base_to_lds(F, args, lbase); \
        MoeOrder S{lbase, (const int*)(ws + WS_CTL) + CW_CNT, (const int*)(ws + WS_LIST), 4, F.G, (int)blockIdx.x, 1, (const char*)(ws + WS_X1B), (const char*)(ws + WS_WGU_T), \
                   (size_t)1024 * DM * 2, 0, (size_t)256 * DM * 2}; \
        EpUp E{(bf16_t*)(ws + WS_H)}; \
        pg8::gemm_phase<EpUp, MoeOrder, true>(F.lds, F.tid, DM, DM * 2, DM * 2, S, E); } while (0)
    PHASE(8, BODY8);

#define BODY9(rep) do { moe_base_to_lds(F, args, lbase); \
        MoeOrder S{lbase, (const int*)(ws + WS_CTL) + CW_CNT, (const int*)(ws + WS_LIST), 8, F.G, (int)blockIdx.x, 0, (const char*)(ws + WS_H), (const char*)(ws + WS_WD_T), \
                   (size_t)DM * DE * 2, (size_t)256 * DE * 2, (size_t)256 * DE * 2}; \
        EpDown E{(bf16_t*)(ws + WS_Y)}; \
        pg8::gemm_phase<EpDown, MoeOrder>(F.lds, F.tid, DE, DE * 2, DE * 2, S, E); } while (0)
    PHASE(9, BODY9);

#define BODY10(rep) do { moe_base_to_lds(F, args, lbase); \
        const int gw = F.vcu * NWAVES + F.wave, NGW = F.G * NWAVES; \
        for (int m = gw; m < T_TOK; m += NGW) ln2_row(F, args, m, lbase); } while (0)
    PHASE(10, BODY10);
#undef IN
#undef SEAM
}

#ifndef RT_DUP
#define RT_DUP (-1)
#endif
static int g_grid = 0;
static bool mega_setup() {
    if (g_grid) return g_grid > 0;
    int dev = 0, cus = 0, per_cu = 0;
    if (hipGetDevice(&dev) != hipSuccess || hipDeviceGetAttribute(&cus, hipDeviceAttributeMultiprocessorCount, dev) != hipSuccess || cus <= 0) { cus = 256; (void)hipGetLastError(); }
    if (hipOccupancyMaxActiveBlocksPerMultiprocessor(&per_cu, (const void*)fwd, NWAVES * 64, 0) != hipSuccess || per_cu < 1) fprintf(stderr, "note: occupancy query reports %d blocks per CU\n", per_cu);
    (void)hipGetLastError();
    g_grid = cus;
    return true;
}
static void launch_mega(void* const* d_in, float* out, unsigned char* ws, hipStream_t st, int lo, int hi, int li, int flag = -1) {
    Args a{};
    for (int i = 0; i < 25; ++i) a.in[i] = (const float*)d_in[i];
    a.out = out; a.ws = ws; a.ph_lo = lo; a.ph_hi = hi; a.li = li; a.pad = flag;
    hipLaunchKernelGGL(fwd, dim3(g_grid), dim3(NWAVES * 64), 0, st, a);
}
extern "C" void kernel_launch(void* const* d_in, const int* in_sizes, int n_in, void* d_out, int out_size, void* d_ws, size_t ws_size, hipStream_t stream) {
    if (n_in != 25 || out_size != T_TOK * DM || ws_size < WS_END) { fprintf(stderr, "kernel_launch: unexpected arguments (n_in %d out %d ws %zu)\n", n_in, out_size, ws_size); return; }
    (void)in_sizes;
    if (!mega_setup()) return;
    (void)hipMemsetAsync((char*)d_ws + WS_CTL, 0, 1 * MiB, stream);
    launch_mega(d_in, (float*)d_out, (unsigned char*)d_ws, stream, 0, 11, 0);
}
```
